# Optimizing an MI355X kernel written in HIP

```python
import jax
import jax.numpy as jnp
from jax import lax
import numpy as np


D_MODEL = 1024
BATCH = 8
SEQ = 2048
DEPTH = 2

CTX_LEN = 256
GRID_W = 64
N_MIXERS = 2
EPS = 1e-6
N_MOD = 6
POOL_WINDOWS = (2, 4, 8, 16)
POOL_GROUPS = 4
POOL_GROUP_DIM = D_MODEL // POOL_GROUPS
MLSTM_HEADS = 8
MLSTM_V_DIM = D_MODEL // MLSTM_HEADS
MLSTM_QK_DIM = MLSTM_V_DIM // 2
MLSTM_QK_WIDTH = MLSTM_HEADS * MLSTM_QK_DIM
MLSTM_V_WIDTH = MLSTM_HEADS * MLSTM_V_DIM
MLSTM_IN_WIDTH = 2 * MLSTM_QK_WIDTH + 2 * MLSTM_V_WIDTH + 4 * MLSTM_HEADS
MLSTM_CHUNK = 64
D_FF = ((8 * D_MODEL // 3 + 255) // 256) * 256
CONV_K = 3
N_POOL_LAYERS = (DEPTH + 1) // 2
N_MLSTM_LAYERS = DEPTH // 2

kernel_name = 'hybrid_pool_mlstm_dit_block'


def _rms_norm(x, g):
    xf = x.astype(jnp.float32)
    y = xf * lax.rsqrt(jnp.mean(xf * xf, axis=-1, keepdims=True) + EPS)
    return (y * g.astype(jnp.float32)).astype(x.dtype)


def _modulation(cond, w, b):
    m = jax.nn.silu(cond) @ w + b
    return jnp.split(m[:, None, :], N_MOD, axis=-1)


def _modulate(h, g, shift, scale):
    return _rms_norm(h, g) * (1 + scale) + shift


def _dwconv_grid(x, w, b, grid):
    B, N, F = x.shape
    R, W = grid
    y = lax.conv_general_dilated(x.reshape(B, R, W, F), w.astype(x.dtype), (1, 1), 'SAME',
                                 dimension_numbers=('NHWC', 'HWIO', 'NHWC'), feature_group_count=F)
    return y.reshape(B, N, F) + b


def _pool_mixer(h, w_groups, scale, grid):
    B, N, D = h.shape
    R, W = grid
    hf = h.astype(jnp.float32).reshape(B, R, W, POOL_GROUPS, POOL_GROUP_DIM)
    csum = jnp.cumsum(hf, axis=2)
    csum = jnp.pad(csum, ((0, 0), (0, 0), (1, 0), (0, 0), (0, 0)))
    pos = np.arange(W)
    outs = []
    for gi, win in enumerate(POOL_WINDOWS):
        lo = np.clip(pos - win // 2, 0, W)
        hi = np.clip(pos - win // 2 + win, 0, W)
        inv_cnt = (1.0 / (hi - lo)).astype(np.float32)[:, None]
        cg = csum[:, :, :, gi]
        mean = (jnp.take(cg, hi, axis=2) - jnp.take(cg, lo, axis=2)) * inv_cnt
        outs.append(mean - hf[:, :, :, gi])
    y = jnp.stack(outs, axis=3).astype(h.dtype)
    y = jnp.einsum('brwgi,gio->brwgo', y, w_groups)
    return y.reshape(B, N, D) * scale


def _mlstm_inputs(h, w_in, b_gate, conv_w, conv_b, grid):
    B, N, _ = h.shape
    z = h @ w_in
    qk, v, o, gates = jnp.split(z, [2 * MLSTM_QK_WIDTH, 2 * MLSTM_QK_WIDTH + MLSTM_V_WIDTH,
                                    2 * MLSTM_QK_WIDTH + 2 * MLSTM_V_WIDTH], axis=-1)
    qk = jax.nn.silu(_dwconv_grid(qk, conv_w, conv_b, grid))
    q, k = jnp.split(qk, 2, axis=-1)

    def heads(a, d):
        return a.reshape(B, N, MLSTM_HEADS, d).transpose(0, 2, 1, 3).astype(jnp.float32)

    q = heads(q, MLSTM_QK_DIM)
    k = heads(k, MLSTM_QK_DIM) * (MLSTM_QK_DIM ** -0.5)
    v = heads(v, MLSTM_V_DIM)
    gates = (gates + b_gate).astype(jnp.float32).reshape(B, N, 4, MLSTM_HEADS).transpose(2, 0, 3, 1)
    return (q, k, v, o, gates[0], gates[1],
            jax.nn.log_sigmoid(gates[2]), jax.nn.log_sigmoid(gates[3]))


def _mlstm_chunkwise(q, k, v, ig, lf, state0, with_output):
    B, H, T, dk = q.shape
    dv = v.shape[-1]
    L = MLSTM_CHUNK
    nc = T // L
    q = q.reshape(B, H, nc, L, dk)
    k = k.reshape(B, H, nc, L, dk)
    v = v.reshape(B, H, nc, L, dv)
    ig = ig.reshape(B, H, nc, L)
    b = jnp.cumsum(lf.reshape(B, H, nc, L), axis=-1)
    b_last = b[..., -1]
    g = b_last[..., None] - b + ig
    g_max = jnp.max(g, axis=-1)
    w_end = jnp.exp(g - g_max[..., None])
    c_chunk = jnp.einsum('bhcsk,bhcsv,bhcs->bhckv', k, v, w_end)
    n_chunk = jnp.einsum('bhcsk,bhcs->bhck', k, w_end)

    def step(carry, xs):
        C, n, m = carry
        bl, gm, cc, ncnk = xs
        m_new = jnp.maximum(bl + m, gm)
        a = jnp.exp(bl + m - m_new)
        e = jnp.exp(gm - m_new)
        C_new = a[..., None, None] * C + e[..., None, None] * cc
        n_new = a[..., None] * n + e[..., None] * ncnk
        return (C_new, n_new, m_new), (C, n, m)

    xs = (jnp.moveaxis(b_last, -1, 0), jnp.moveaxis(g_max, -1, 0),
          jnp.moveaxis(c_chunk, 2, 0), jnp.moveaxis(n_chunk, 2, 0))
    state_f, (c_prev, n_prev, m_prev) = lax.scan(step, state0, xs)
    if not with_output:
        return None, state_f
    c_prev = jnp.moveaxis(c_prev, 0, 2)
    n_prev = jnp.moveaxis(n_prev, 0, 2)
    m_prev = jnp.moveaxis(m_prev, 0, -1)
    mask = np.tril(np.ones((L, L), dtype=bool))
    log_d = jnp.where(mask, b[..., :, None] - b[..., None, :] + ig[..., None, :], -jnp.inf)
    inter_log = b + m_prev[..., None]
    m_t = jnp.maximum(inter_log, jnp.max(log_d, axis=-1))
    d_w = jnp.exp(log_d - m_t[..., None])
    a_t = jnp.exp(inter_log - m_t)
    s = jnp.einsum('bhctk,bhcsk->bhcts', q, k) * d_w
    num = jnp.einsum('bhcts,bhcsv->bhctv', s, v) + a_t[..., None] * jnp.einsum('bhctk,bhckv->bhctv', q, c_prev)
    den = jnp.sum(s, axis=-1) + a_t * jnp.einsum('bhctk,bhck->bhct', q, n_prev)
    h = num / jnp.maximum(jnp.abs(den), jnp.exp(-m_t))[..., None]
    return h.reshape(B, H, T, dv), state_f


def _mlstm_mixer(h, w_in, b_gate, conv_w, conv_b, w_out, grid, state_f0, state_b0, with_output):
    q, k, v, o, ig_f, ig_b, lf_f, lf_b = _mlstm_inputs(h, w_in, b_gate, conv_w, conv_b, grid)
    h_f, st_f = _mlstm_chunkwise(q, k, v, ig_f, lf_f, state_f0, with_output)
    flip = lambda a: jnp.flip(a, axis=2)
    h_b, st_b = _mlstm_chunkwise(flip(q), flip(k), flip(v), flip(ig_b), flip(lf_b), state_b0, with_output)
    if not with_output:
        return None, st_f, st_b
    hs = h_f + flip(h_b)
    B, H, N, dv = hs.shape
    hs = hs.transpose(0, 2, 1, 3).reshape(B, N, H * dv).astype(h.dtype)
    return (jax.nn.sigmoid(o) * hs) @ w_out, st_f, st_b


def _zero_state(batch):
    return (jnp.zeros((batch, MLSTM_HEADS, MLSTM_QK_DIM, MLSTM_V_DIM), jnp.float32),
            jnp.zeros((batch, MLSTM_HEADS, MLSTM_QK_DIM), jnp.float32),
            jnp.zeros((batch, MLSTM_HEADS), jnp.float32))


def _conv_ffn(h, w_in, conv_w, conv_b, w_out, grid):
    u, g = jnp.split(h @ w_in, 2, axis=-1)
    g = _dwconv_grid(g, conv_w, conv_b, grid)
    return (jax.nn.silu(g) * u) @ w_out


def setup_inputs(seed: int = 0) -> dict:
    key = jax.random.key(seed)
    ks = jax.random.split(key, 20)
    nrm = jax.random.normal
    f32 = jnp.float32
    b_gate = jnp.concatenate([0.1 * nrm(ks[10], (N_MLSTM_LAYERS, 2 * MLSTM_HEADS), f32),
                              3.0 + 0.5 * nrm(ks[11], (N_MLSTM_LAYERS, 2 * MLSTM_HEADS), f32)], axis=-1)
    return {
        'x': nrm(ks[0], (BATCH, SEQ, D_MODEL), f32),
        'c': nrm(ks[1], (BATCH, D_MODEL), f32),
        'ctx': nrm(ks[2], (BATCH, CTX_LEN, D_MODEL), f32),
        'c_ctx': nrm(ks[3], (D_MODEL,), f32),
        'mod_w': nrm(ks[4], (DEPTH, D_MODEL, N_MOD * D_MODEL), f32) * D_MODEL ** -0.5,
        'mod_b': 0.02 * nrm(ks[5], (DEPTH, N_MOD * D_MODEL), f32),
        'norm_g': 1.0 + 0.05 * nrm(ks[6], (DEPTH, 4, D_MODEL), f32),
        'pool_w': nrm(ks[7], (N_POOL_LAYERS, POOL_GROUPS, POOL_GROUP_DIM, POOL_GROUP_DIM), f32) * POOL_GROUP_DIM ** -0.5,
        'pool_scale': 1.0 + 0.05 * nrm(ks[8], (N_POOL_LAYERS, D_MODEL), f32),
        'mlstm_w_in': nrm(ks[9], (N_MLSTM_LAYERS, D_MODEL, MLSTM_IN_WIDTH), f32) * D_MODEL ** -0.5,
        'mlstm_b_gate': b_gate,
        'mlstm_conv_w': nrm(ks[12], (N_MLSTM_LAYERS, CONV_K, CONV_K, 1, 2 * MLSTM_QK_WIDTH), f32) / CONV_K,
        'mlstm_conv_b': 0.02 * nrm(ks[13], (N_MLSTM_LAYERS, 2 * MLSTM_QK_WIDTH), f32),
        'mlstm_w_out': nrm(ks[14], (N_MLSTM_LAYERS, MLSTM_V_WIDTH, D_MODEL), f32) * MLSTM_V_WIDTH ** -0.5,
        'ffn_w_in': nrm(ks[15], (DEPTH, D_MODEL, 2 * D_FF), f32) * D_MODEL ** -0.5,
        'ffn_conv_w': nrm(ks[16], (DEPTH, CONV_K, CONV_K, 1, D_FF), f32) / CONV_K,
        'ffn_conv_b': 0.02 * nrm(ks[17], (DEPTH, D_FF), f32),
        'ffn_w_out': nrm(ks[18], (DEPTH, D_FF, D_MODEL), f32) * D_FF ** -0.5,
    }


def reference(x, c, ctx, c_ctx, mod_w, mod_b, norm_g, pool_w, pool_scale, mlstm_w_in, mlstm_b_gate,
              mlstm_conv_w, mlstm_conv_b, mlstm_w_out, ffn_w_in, ffn_conv_w, ffn_conv_b, ffn_w_out):
    B, N, _ = x.shape
    ROWS = N // GRID_W
    grid_x = (ROWS, GRID_W)
    grid_c = (1, ctx.shape[1])
    for i in range(DEPTH):
        last = i == DEPTH - 1
        j = i // N_MIXERS
        use_pool = i % N_MIXERS == 0
        ctx_out = not last
        ctx_read = ctx_out or not use_pool
        sh1, sc1, gt1, sh2, sc2, gt2 = _modulation(c, mod_w[i], mod_b[i])
        hx = _modulate(x, norm_g[i, 0], sh1, sc1)
        if ctx_read:
            csh1, csc1, cgt1, csh2, csc2, cgt2 = _modulation(c_ctx[None, :], mod_w[i], mod_b[i])
            hc = _modulate(ctx, norm_g[i, 0], csh1, csc1)
        if use_pool:
            yx = _pool_mixer(hx, pool_w[j], pool_scale[j], grid_x)
            yc = _pool_mixer(hc, pool_w[j], pool_scale[j], grid_c) if ctx_out else None
        else:
            z0 = _zero_state(B)
            yc, st_f, st_b = _mlstm_mixer(hc, mlstm_w_in[j], mlstm_b_gate[j], mlstm_conv_w[j], mlstm_conv_b[j],
                                          mlstm_w_out[j], grid_c, z0, z0, ctx_out)
            yx, _, _ = _mlstm_mixer(hx, mlstm_w_in[j], mlstm_b_gate[j], mlstm_conv_w[j], mlstm_conv_b[j],
                                    mlstm_w_out[j], grid_x, st_f, st_b, True)
        x = x + gt1 * _rms_norm(yx, norm_g[i, 1])
        fx = _conv_ffn(_modulate(x, norm_g[i, 2], sh2, sc2), ffn_w_in[i], ffn_conv_w[i], ffn_conv_b[i], ffn_w_out[i], grid_x)
        x = x + gt2 * _rms_norm(fx, norm_g[i, 3])
        if ctx_out:
            ctx = ctx + cgt1 * _rms_norm(yc, norm_g[i, 1])
            fc = _conv_ffn(_modulate(ctx, norm_g[i, 2], csh2, csc2), ffn_w_in[i], ffn_conv_w[i], ffn_conv_b[i], ffn_w_out[i], grid_c)
            ctx = ctx + cgt2 * _rms_norm(fc, norm_g[i, 3])
    return x
```

```cpp
#include <hip/hip_runtime.h>
#include <cstdio>
#include <cstdint>

#define LAS __attribute__((address_space(3)))
typedef unsigned short bf16_t;
typedef short bf16x8 __attribute__((ext_vector_type(8)));
typedef float f32x4 __attribute__((ext_vector_type(4)));
typedef float f32x2 __attribute__((ext_vector_type(2)));
typedef unsigned u32x4 __attribute__((ext_vector_type(4)));
typedef unsigned u32x2 __attribute__((ext_vector_type(2)));

constexpr int D = 1024, NB = 8, SEQ = 2048, CTXL = 256, GWID = 64;
constexpr int MX = NB * SEQ, MC = NB * CTXL, MT = MX + MC;
constexpr int DFF = 2816, NFF = 2 * DFF;
constexpr int NH = 8, INW = 3104, INWP = 3328, ZW = 3072;
constexpr int NMOD = 6 * D;
constexpr float EPS = 1e-6f;
constexpr int NWAVES = 8, NTHREADS = 512;

constexpr size_t MiB = 1u << 20;
constexpr size_t WS_CTL = 0, CTL_ZERO_BYTES = 64 * 1024;
constexpr size_t WS_MOD = 1 * MiB;
constexpr size_t WS_XC = 2 * MiB;
constexpr size_t WS_WP = 10 * MiB;
constexpr size_t WS_WF1 = 11 * MiB;
constexpr size_t WS_WF2A = 11 * MiB;
constexpr size_t WS_H = 22 * MiB;
constexpr size_t WS_BIG = 58 * MiB;
constexpr size_t WS_UG0 = 58 * MiB;
constexpr size_t WS_Y0 = 58 * MiB;
constexpr size_t WS_WI = 58 * MiB;
constexpr size_t WS_WO = 65 * MiB;
constexpr size_t WS_WF2B = 67 * MiB;
constexpr size_t WS_Z = 73 * MiB;
constexpr size_t WS_Y1 = 73 * MiB;
constexpr size_t WS_GT = 181 * MiB;
constexpr size_t WS_HF = 187 * MiB;
constexpr size_t WS_HB = 219 * MiB;
constexpr size_t WS_UG1 = 80 * MiB;
constexpr size_t WS_END = 256 * MiB;
static_assert(WS_UG0 + (size_t)MT * NFF * 2 <= WS_END, "ug0");
static_assert(WS_UG1 + (size_t)MX * NFF * 2 <= WS_END, "ug1");
static_assert(WS_HB + (size_t)MX * D * 2 <= WS_END, "hb");
static_assert(WS_H + (size_t)MT * D * 2 <= WS_BIG, "h");
static_assert(WS_Z + (size_t)MT * ZW * 2 <= WS_GT, "z");
static_assert(WS_GT + (size_t)MT * 32 * 4 <= WS_HF, "gt");

enum { PH_P0 = 0, PH_POOL, PH_G1, PH_E2, PH_G2, PH_E3, PH_G3, PH_E4, PH_G4, PH_E5, PH_MLSTM, PH_E6, PH_G5, PH_E7, PH_G6, PH_E8, PH_G7, PH_E9, NPH };

struct P {
    const float* in[18];
    float* out;
    unsigned char* ws;
    int lo, hi;
};
enum { I_X = 0, I_C, I_CTX, I_CCTX, I_MODW, I_MODB, I_NORMG, I_POOLW, I_POOLS, I_MWIN, I_MBG, I_MCW, I_MCB, I_MWOUT, I_FWIN, I_FCW, I_FCB, I_FWOUT };

__device__ __forceinline__ unsigned f2bf(float f) { unsigned u = __builtin_bit_cast(unsigned, f); return (u + 0x7fffu + ((u >> 16) & 1u)) >> 16; }
__device__ __forceinline__ unsigned pk2(float lo, float hi) { return f2bf(lo) | (f2bf(hi) << 16); }
__device__ __forceinline__ float bf2f(unsigned short h) { return __builtin_bit_cast(float, (unsigned)h << 16); }
__device__ __forceinline__ float bflo(unsigned w) { return __builtin_bit_cast(float, w << 16); }
__device__ __forceinline__ float bfhi(unsigned w) { return __builtin_bit_cast(float, w & 0xffff0000u); }
__device__ __forceinline__ float wave_sum(float v) {
#pragma unroll
    for (int o = 1; o < 64; o <<= 1) v += __shfl_xor(v, o);
    return v;
}
__device__ __forceinline__ float silu_f(float x) { return x / (1.f + __expf(-x)); }
__device__ __forceinline__ float sigmoid_f(float x) { return 1.f / (1.f + __expf(-x)); }
__device__ __forceinline__ float logsigmoid_f(float x) { return fminf(x, 0.f) - log1pf(__expf(-fabsf(x))); }
__device__ __forceinline__ int mrow_of(int r) { return r < MX ? (r >> 11) : 8; }
#define LDS_WAIT() asm volatile("s_waitcnt lgkmcnt(0)" ::: "memory")

namespace pg8 {
constexpr int BM = 256, BK = 64, HALF = 128, HTB = HALF * BK * 2, STAGE_BYTES = 8 * HTB, NXCD = 8, WGM = 8;
__host__ __device__ __forceinline__ int lds_byte(int r, int c) { const int st = (r >> 4) * 2 + (c >> 5), rr = r & 15, cc = c & 31, ob = rr * 64 + cc * 2; return st * 1024 + (ob ^ (((ob >> 9) & 1) << 5)); }
__host__ __device__ __forceinline__ void stage_rc(int b, int& R, int& C) { const int st = b / 1024, sb = b % 1024, swz = sb ^ (((sb >> 9) & 1) << 5); R = (st >> 1) * 16 + swz / 64; C = (st & 1) * 32 + (swz % 64) / 2; }
__host__ __device__ __forceinline__ int perm32(int rho) { const int n = rho >> 4, i = rho & 15; return 8 * (i >> 2) + 4 * n + (i & 3); }
struct Unit { int pm, pn; };
struct Gemm { const bf16_t* A; const bf16_t* Bt; int M, N, K, lda, ldb, akoff; };
struct StaticOrder {
    int nM, nN, nwg, G, c;
    __host__ __device__ void init(int M, int N, int G_, int c_) { nM = M / BM; nN = N / BM; nwg = nM * nN; G = G_; c = c_; }
    __host__ __device__ bool next(int i, Unit& u) const {
        const long L = (long)i * G + c; if (L >= nwg) return false;
        int wgid = (int)L; { const int q = nwg / NXCD, r = nwg % NXCD, xcd = wgid % NXCD, off = wgid / NXCD; wgid = (xcd < r ? xcd * (q + 1) : r * (q + 1) + (xcd - r) * q) + off; }
        const int nig = WGM * nN, gid = wgid / nig, fm = gid * WGM, gsz = (nM - fm) < WGM ? (nM - fm) : WGM;
        u.pm = fm + ((wgid % nig) % gsz); u.pn = (wgid % nig) / gsz; return true;
    }
};
__device__ __forceinline__ unsigned cvt_pk_bf16(float lo, float hi) { unsigned r; asm volatile("v_cvt_pk_bf16_f32 %0, %1, %2" : "=v"(r) : "v"(lo), "v"(hi)); return r; }

struct EpiF32 {
    static constexpr bool PERM = false;
    float* O; int ldc;
    __device__ __forceinline__ void operator()(const f32x4 (&acc)[2][2][4][2], const Unit& u, int wr, int wc, int fr, int fq) const {
        const int row0 = u.pm * BM + wr * 64 + fr, col0 = u.pn * BM + wc * 32 + 4 * fq;
#pragma unroll
        for (int ai = 0; ai < 2; ++ai)
#pragma unroll
            for (int m = 0; m < 4; ++m) { float* rowp = O + (size_t)(row0 + ai * HALF + m * 16) * ldc + col0;
#pragma unroll
                for (int bj = 0; bj < 2; ++bj)
#pragma unroll
                    for (int n = 0; n < 2; ++n) *(f32x4*)(rowp + bj * HALF + n * 16) = acc[ai][bj][m][n]; }
    }
};
struct EpiBf16 {
    static constexpr bool PERM = true;
    bf16_t* O; int ldc;
    __device__ __forceinline__ void operator()(const f32x4 (&acc)[2][2][4][2], const Unit& u, int wr, int wc, int fr, int fq) const {
        const int row0 = u.pm * BM + wr * 64 + fr, col0 = u.pn * BM + wc * 32 + 8 * fq;
#pragma unroll
        for (int ai = 0; ai < 2; ++ai)
#pragma unroll
            for (int m = 0; m < 4; ++m) { bf16_t* rowp = O + (size_t)(row0 + ai * HALF + m * 16) * ldc + col0;
#pragma unroll
                for (int bj = 0; bj < 2; ++bj) { const f32x4 v0 = acc[ai][bj][m][0], v1 = acc[ai][bj][m][1];
                    u32x4 w; w.x = cvt_pk_bf16(v0[0], v0[1]); w.y = cvt_pk_bf16(v0[2], v0[3]); w.z = cvt_pk_bf16(v1[0], v1[1]); w.w = cvt_pk_bf16(v1[2], v1[3]);
                    *(u32x4*)(rowp + bj * HALF) = w; } }
    }
};
struct EpiZ {
    static constexpr bool PERM = true;
    bf16_t* Z; float* GT;
    __device__ __forceinline__ void operator()(const f32x4 (&acc)[2][2][4][2], const Unit& u, int wr, int wc, int fr, int fq) const {
        const int row0 = u.pm * BM + wr * 64 + fr;
        if (u.pn < 12) {
            const int col0 = u.pn * BM + wc * 32 + 8 * fq;
#pragma unroll
            for (int ai = 0; ai < 2; ++ai)
#pragma unroll
                for (int m = 0; m < 4; ++m) { bf16_t* rowp = Z + (size_t)(row0 + ai * HALF + m * 16) * ZW + col0;
#pragma unroll
                    for (int bj = 0; bj < 2; ++bj) { const f32x4 v0 = acc[ai][bj][m][0], v1 = acc[ai][bj][m][1];
                        u32x4 w; w.x = cvt_pk_bf16(v0[0], v0[1]); w.y = cvt_pk_bf16(v0[2], v0[3]); w.z = cvt_pk_bf16(v1[0], v1[1]); w.w = cvt_pk_bf16(v1[2], v1[3]);
                        *(u32x4*)(rowp + bj * HALF) = w; } }
        } else if (wc == 0) {
#pragma unroll
            for (int ai = 0; ai < 2; ++ai)
#pragma unroll
                for (int m = 0; m < 4; ++m) { float* rowp = GT + (size_t)(row0 + ai * HALF + m * 16) * 32 + 8 * fq;
                    *(f32x4*)(rowp) = acc[ai][0][m][0]; *(f32x4*)(rowp + 4) = acc[ai][0][m][1]; }
        }
    }
};

template <class Epi, class Sched, bool ALIGN_EPI>
__device__ __forceinline__ void gemm_phase(LAS unsigned char* lds, const Gemm g, const Sched& S, const Epi& E) {
    const int tid = threadIdx.x, wid = __builtin_amdgcn_readfirstlane(tid >> 6), lane = tid & 63, wr = wid >> 2, wc = wid & 3, fr = lane & 15, fq = lane >> 4;
    const int K = g.K, nt = K / BK;
    unsigned voffA[2], voffB[2];
#pragma unroll
    for (int i = 0; i < 2; ++i) { int R, C; stage_rc(tid * 16 + i * 8192, R, C); const int Rb = Epi::PERM ? ((R & ~31) + perm32(R & 31)) : R;
        voffA[i] = (unsigned)(R * g.lda + C) * 2u; voffB[i] = (unsigned)(Rb * g.ldb + C) * 2u; }
    const size_t kstep = (size_t)(BK * 2);
    const size_t hstepA = (size_t)HALF * g.lda * 2, hstepB = (size_t)HALF * g.ldb * 2;
    const size_t tstepA = 2 * hstepA, tstepB = 2 * hstepB;
    const size_t akoffb = (size_t)g.akoff * 2;
    const unsigned ldsw = (unsigned)wid * 1024u;
    const int aoff = lds_byte(wr * 64 + fr, fq * 8), boff = lds_byte(wc * 32 + fr, fq * 8);
#define PG8_SA(b, h) (((b) * 2 + (h)) * HTB)
#define PG8_SB(b, h) ((4 + (b) * 2 + (h)) * HTB)
#define PG8_STAGE(bufoff, gbase, voff) do { _Pragma("unroll") for (int _i = 0; _i < 2; ++_i) \
        __builtin_amdgcn_global_load_lds((const unsigned*)((const char*)(gbase) + (voff)[_i]), (LAS unsigned*)(lds + (bufoff) + ldsw + _i * 8192), 16, 0, 0); } while (0)
#define PG8_LDA(dst, b, h) do { _Pragma("unroll") for (int m = 0; m < 4; ++m) _Pragma("unroll") for (int k = 0; k < 2; ++k) dst[m][k] = *(const LAS bf16x8*)(lds + PG8_SA(b, h) + aoff + m * 2048 + k * 1024); } while (0)
#define PG8_LDB(dst, b, h) do { _Pragma("unroll") for (int n = 0; n < 2; ++n) _Pragma("unroll") for (int k = 0; k < 2; ++k) dst[n][k] = *(const LAS bf16x8*)(lds + PG8_SB(b, h) + boff + n * 2048 + k * 1024); } while (0)
#define PG8_MMA(ai, bj, At, Bt) do { __builtin_amdgcn_s_setprio(1); _Pragma("unroll") for (int m = 0; m < 4; ++m) _Pragma("unroll") for (int n = 0; n < 2; ++n) _Pragma("unroll") for (int k = 0; k < 2; ++k) \
        acc[ai][bj][m][n] = __builtin_amdgcn_mfma_f32_16x16x32_bf16(Bt[n][k], At[m][k], acc[ai][bj][m][n], 0, 0, 0); __builtin_amdgcn_s_setprio(0); } while (0)
#define PG8_WAIT_V(n) asm volatile("s_waitcnt vmcnt(" #n ")" ::: "memory")
#define PG8_WAIT_L(n) asm volatile("s_waitcnt lgkmcnt(" #n ")" ::: "memory")
#define PG8_BAR __builtin_amdgcn_s_barrier()
#define PG8_SCHED __builtin_amdgcn_sched_barrier(0)
    Unit cur, nxt; int ui = 0;
    if (!S.next(0, cur)) return;
    f32x4 acc[2][2][4][2];
#pragma unroll
    for (int a = 0; a < 2; ++a)
#pragma unroll
        for (int b = 0; b < 2; ++b)
#pragma unroll
            for (int m = 0; m < 4; ++m)
#pragma unroll
                for (int n = 0; n < 2; ++n) acc[a][b][m][n] = (f32x4){0.f, 0.f, 0.f, 0.f};
    bf16x8 At[4][2], B0[2][2], B1[2][2];
    const char* cA = (const char*)g.A + (size_t)cur.pm * tstepA + (size_t)cur.pn * akoffb; const char* cB = (const char*)g.Bt + (size_t)cur.pn * tstepB;
    PG8_STAGE(PG8_SB(0, 0), cB, voffB); PG8_STAGE(PG8_SB(0, 1), cB + hstepB, voffB); PG8_STAGE(PG8_SA(0, 0), cA, voffA); PG8_STAGE(PG8_SA(0, 1), cA + hstepA, voffA);
    if (wr == 1) PG8_BAR;
    PG8_WAIT_V(2); PG8_BAR;
    PG8_STAGE(PG8_SB(1, 0), cB + kstep, voffB); PG8_STAGE(PG8_SA(1, 0), cA + kstep, voffA); PG8_STAGE(PG8_SB(1, 1), cB + hstepB + kstep, voffB);
    PG8_WAIT_V(6); PG8_BAR;
    for (;;) {
        const bool has_next = S.next(ui + 1, nxt);
        const char* nA = has_next ? (const char*)g.A + (size_t)nxt.pm * tstepA + (size_t)nxt.pn * akoffb : cA; const char* nB = has_next ? (const char*)g.Bt + (size_t)nxt.pn * tstepB : cB;
        for (int t = 0; t < nt; t += 2) {
            const bool last = (t == nt - 2);
            const char* a1 = cA + (size_t)(t + 1) * kstep;
            const char* a2 = last ? nA : cA + (size_t)(t + 2) * kstep; const char* b2 = last ? nB : cB + (size_t)(t + 2) * kstep;
            const char* a3 = a2 + kstep; const char* b3 = b2 + kstep;
            PG8_LDB(B0, 0, 0); PG8_LDB(B1, 0, 1); PG8_SCHED; PG8_LDA(At, 0, 0); PG8_STAGE(PG8_SA(1, 1), a1 + hstepA, voffA);
            PG8_WAIT_V(8); PG8_WAIT_L(0); PG8_BAR; PG8_MMA(0, 0, At, B0); PG8_MMA(0, 1, At, B1); PG8_BAR; PG8_SCHED;
            PG8_LDA(At, 0, 1); PG8_STAGE(PG8_SB(0, 0), b2, voffB); PG8_STAGE(PG8_SB(0, 1), b2 + hstepB, voffB); PG8_STAGE(PG8_SA(0, 0), a2, voffA);
            PG8_WAIT_V(8); PG8_WAIT_L(0); PG8_BAR; PG8_MMA(1, 0, At, B0); PG8_MMA(1, 1, At, B1); PG8_BAR; PG8_SCHED;
            PG8_LDB(B0, 1, 0); PG8_LDB(B1, 1, 1); PG8_SCHED; PG8_LDA(At, 1, 0); PG8_STAGE(PG8_SA(0, 1), a2 + hstepA, voffA);
            PG8_WAIT_V(8); PG8_WAIT_L(0); PG8_BAR; PG8_MMA(0, 0, At, B0); PG8_MMA(0, 1, At, B1); PG8_BAR; PG8_SCHED;
            PG8_LDA(At, 1, 1); PG8_STAGE(PG8_SB(1, 0), b3, voffB); PG8_STAGE(PG8_SB(1, 1), b3 + hstepB, voffB); PG8_STAGE(PG8_SA(1, 0), a3, voffA);
            PG8_WAIT_V(8); PG8_WAIT_L(0); PG8_BAR; PG8_MMA(1, 0, At, B0); PG8_MMA(1, 1, At, B1); PG8_BAR; PG8_SCHED;
        }
        if constexpr (ALIGN_EPI) { if (wr == 0) PG8_BAR; }
        E(acc, cur, wr, wc, fr, fq);
        if (!has_next) break;
#pragma unroll
        for (int a = 0; a < 2; ++a)
#pragma unroll
            for (int b = 0; b < 2; ++b)
#pragma unroll
                for (int m = 0; m < 4; ++m)
#pragma unroll
                    for (int n = 0; n < 2; ++n) acc[a][b][m][n] = (f32x4){0.f, 0.f, 0.f, 0.f};
        cur = nxt; cA = nA; cB = nB; ++ui;
        if constexpr (ALIGN_EPI) { if (wr == 1) PG8_BAR; }
    }
    PG8_WAIT_V(0);
    if constexpr (!ALIGN_EPI) { if (wr == 0) PG8_BAR; }
    PG8_BAR;
#undef PG8_SA
#undef PG8_SB
#undef PG8_STAGE
#undef PG8_LDA
#undef PG8_LDB
#undef PG8_MMA
#undef PG8_WAIT_V
#undef PG8_WAIT_L
#undef PG8_BAR
#undef PG8_SCHED
}
}

constexpr int RING_OFF = 0, RING_BYTES = 131072;
constexpr int LDSCTL_OFF = RING_BYTES, MISC_OFF = LDSCTL_OFF + 320;
constexpr int LDS_BYTES = 147456;
constexpr int CW_BAR = 4096;
#define XB_TMO      128
#define XB_XCNT(j)  (256  + 64 * (j))
#define XB_XSUB(j)  (1280 + 64 * (j))
#define XB_XGEN(j)  (2304 + 64 * (j))
#define XB_TOP      3328
#define XB_TOPGEN   3392
#define XCD_BAR_WORDS 3456
#define XB_SPIN_CAP (1u << 18)
__device__ __forceinline__ unsigned xb_ld(unsigned* p)              { return __hip_atomic_load(p, __ATOMIC_RELAXED, __HIP_MEMORY_SCOPE_AGENT); }
__device__ __forceinline__ unsigned xb_add(unsigned* p, unsigned v) { return __hip_atomic_fetch_add(p, v, __ATOMIC_RELAXED, __HIP_MEMORY_SCOPE_AGENT); }
__device__ __forceinline__ unsigned xb_xcc_id() { return (unsigned)__builtin_amdgcn_s_getreg((3 << 11) | 20) & 0xFu; }
#define XB_SPIN(cond, bar) do { unsigned _sp = 0; while (cond) { __builtin_amdgcn_s_sleep(1); \
    if ((++_sp & 255u) == 0u) { if (xb_ld(&(bar)[XB_TMO])) break; if (_sp > XB_SPIN_CAP) { atomicAdd(&(bar)[XB_TMO], 1u); break; } } } } while (0)
struct XcdBarrier { unsigned* bar; unsigned x; volatile LAS unsigned* st; };
__device__ __forceinline__ XcdBarrier xcd_barrier_post(unsigned* bar, volatile LAS unsigned* st) {
    XcdBarrier b; b.bar = bar; b.x = xb_xcc_id(); b.st = st;
    if (threadIdx.x == 0) (void)xb_add(&bar[XB_XCNT(b.x)], 1u);
    return b;
}
__device__ __forceinline__ void xcd_barrier_complete(unsigned* bar, unsigned x, unsigned& nloc, unsigned& nx) {
    const unsigned G = gridDim.x * gridDim.y * gridDim.z;
    unsigned sum, cnt, mine, sp = 0u;
    for (;;) {
        sum = 0u; cnt = 0u; mine = 0u;
#pragma unroll
        for (unsigned j = 0; j < 16; ++j) { const unsigned c = xb_ld(&bar[XB_XCNT(j)]); sum += c; cnt += (c > 0u) ? 1u : 0u; mine = (j == x) ? c : mine; }
        if (sum == G) break;
        __builtin_amdgcn_s_sleep(1);
        if ((++sp & 255u) == 0u) { if (xb_ld(&bar[XB_TMO])) break; if (sp > XB_SPIN_CAP) { atomicAdd(&bar[XB_TMO], 1u); break; } }
    }
    nloc = mine > 0u ? mine : 1u; nx = cnt > 0u ? cnt : 1u;
}
__device__ __forceinline__ void xcd_barrier(const XcdBarrier& b) {
    asm volatile("s_waitcnt vmcnt(0)" ::: "memory");
    __syncthreads();
    if (threadIdx.x == 0) {
        unsigned* bar = b.bar;
        __builtin_amdgcn_s_waitcnt(0);
        unsigned nloc = b.st[0], nx = b.st[1];
        if (nloc == 0u) { xcd_barrier_complete(bar, b.x, nloc, nx); b.st[0] = nloc; b.st[1] = nx; }
        const unsigned old = xb_add(&bar[XB_XSUB(b.x)], 1u);
        const unsigned gen = old / nloc;
        if (old + 1u == (gen + 1u) * nloc) {
            __builtin_amdgcn_fence(__ATOMIC_RELEASE, "agent");
            asm volatile("s_waitcnt vmcnt(0)" ::: "memory");
            const unsigned og = xb_add(&bar[XB_TOP], 1u);
            const unsigned tg = og / nx;
            if (og + 1u == (tg + 1u) * nx) xb_add(&bar[XB_TOPGEN], 1u);
            else XB_SPIN(xb_ld(&bar[XB_TOPGEN]) == tg, bar);
            __builtin_amdgcn_fence(__ATOMIC_ACQUIRE, "agent");
            xb_add(&bar[XB_XGEN(b.x)], 1u);
            asm volatile("s_waitcnt vmcnt(0)" ::: "memory");
        } else {
            XB_SPIN(xb_ld(&bar[XB_XGEN(b.x)]) == gen, bar);
            __builtin_amdgcn_fence(__ATOMIC_ACQUIRE, "agent");
            asm volatile("s_waitcnt vmcnt(0)" ::: "memory");
        }
    }
    __syncthreads();
}

struct Frame {
    LAS unsigned char* lds;
    int tid, lane, wave, vcu, G, gw, NGW;
    const float* in[18];
    float* out; unsigned char* ws;
};
__device__ __forceinline__ const float* src_row(const Frame& F, int r) {
    return r < MX ? F.in[I_X] + (size_t)r * D : F.in[I_CTX] + (size_t)(r - MX) * D;
}
__device__ __forceinline__ float* stream_row(const Frame& F, int r) {
    return r < MX ? F.out + (size_t)r * D : (float*)(F.ws + WS_XC) + (size_t)(r - MX) * D;
}
__device__ __forceinline__ const float* modp(const Frame& F, int layer, int mrow, int idx) {
    return (const float*)(F.ws + WS_MOD) + ((size_t)(layer * 9 + mrow) * NMOD + idx * D);
}
__device__ __forceinline__ void ld_row(const float* p, int lane, f32x4 (&v)[4]) {
#pragma unroll
    for (int j = 0; j < 4; ++j) v[j] = ((const f32x4*)p)[64 * j + lane];
}
__device__ __forceinline__ void st_row(float* p, int lane, const f32x4 (&v)[4]) {
#pragma unroll
    for (int j = 0; j < 4; ++j) ((f32x4*)p)[64 * j + lane] = v[j];
}
__device__ __forceinline__ void ld_row_bf(const bf16_t* p, int lane, f32x4 (&v)[4]) {
#pragma unroll
    for (int j = 0; j < 4; ++j) { const u32x2 w = ((const u32x2*)p)[64 * j + lane]; v[j] = (f32x4){bflo(w.x), bfhi(w.x), bflo(w.y), bfhi(w.y)}; }
}
__device__ __forceinline__ void st_row_bf(bf16_t* p, int lane, const f32x4 (&v)[4]) {
#pragma unroll
    for (int j = 0; j < 4; ++j) { u32x2 w; w.x = pk2(v[j][0], v[j][1]); w.y = pk2(v[j][2], v[j][3]); ((u32x2*)p)[64 * j + lane] = w; }
}
__device__ __forceinline__ float sumsq(const f32x4 (&v)[4]) {
    float s = 0.f;
#pragma unroll
    for (int j = 0; j < 4; ++j) s += (v[j][0] * v[j][0] + v[j][1] * v[j][1]) + (v[j][2] * v[j][2] + v[j][3] * v[j][3]);
    return s;
}
__device__ __forceinline__ void modulate_row_bf(const f32x4 (&x)[4], float rstd, const float* g, const float* sc, const float* sh, int lane, bf16_t* o) {
    f32x4 gv[4], scv[4], shv[4], h[4];
    ld_row(g, lane, gv); ld_row(sc, lane, scv); ld_row(sh, lane, shv);
#pragma unroll
    for (int j = 0; j < 4; ++j) h[j] = x[j] * rstd * gv[j] * (scv[j] + 1.f) + shv[j];
    st_row_bf(o, lane, h);
}

__device__ __forceinline__ void transpose_item(const float* W, int K, int N, bf16_t* WT, int row_off, LAS float* scr, int item, int lane) {
    const int nblk = N / 32, kb = item / nblk, nb = item % nblk, k0 = 64 * kb, n0 = 32 * nb;
#pragma unroll 8
    for (int i = 0; i < 32; ++i) { const int kk = 2 * i + (lane >> 5); scr[kk * 33 + (lane & 31)] = W[(size_t)(k0 + kk) * N + n0 + (lane & 31)]; }
    LDS_WAIT(); asm volatile("" ::: "memory");
    const int c = lane & 7;
#pragma unroll
    for (int j = 0; j < 4; ++j) { const int n = (lane >> 3) + 8 * j; const LAS float* s = scr + (8 * c) * 33 + n;
        u32x4 o; o.x = pk2(s[0 * 33], s[1 * 33]); o.y = pk2(s[2 * 33], s[3 * 33]); o.z = pk2(s[4 * 33], s[5 * 33]); o.w = pk2(s[6 * 33], s[7 * 33]);
        *(u32x4*)(WT + (size_t)(row_off + n0 + n) * K + k0 + 8 * c) = o; }
    LDS_WAIT(); asm volatile("" ::: "memory");
}

__device__ __forceinline__ void ph_p0(Frame& F) {
    LAS float* S = (LAS float*)(F.lds);
    LAS float* red = (LAS float*)(F.lds + 9 * 1024 * 4);
    if (F.vcu < 192) {
        for (int i = F.tid; i < 9 * 1024; i += NTHREADS) { const int r = i >> 10, k = i & 1023; const float c = r < 8 ? F.in[I_C][r * D + k] : F.in[I_CCTX][k]; S[i] = silu_f(c); }
        __syncthreads();
        for (int it = F.vcu; it < 192; it += F.G) {
            const int l = it / 96, j0 = (it % 96) * 64;
            const float* W = F.in[I_MODW] + (size_t)l * D * NMOD + j0 + F.lane;
            float acc[9];
#pragma unroll
            for (int r = 0; r < 9; ++r) acc[r] = 0.f;
            const int kb = F.wave * 128;
#pragma unroll 8
            for (int k = 0; k < 128; ++k) { const float w = W[(size_t)(kb + k) * NMOD];
#pragma unroll
                for (int r = 0; r < 9; ++r) acc[r] += S[r * 1024 + kb + k] * w; }
#pragma unroll
            for (int r = 0; r < 9; ++r) red[(F.wave * 9 + r) * 64 + F.lane] = acc[r];
            __syncthreads();
            for (int i = F.tid; i < 9 * 64; i += NTHREADS) { const int r = i >> 6, ln = i & 63; float s = F.in[I_MODB][l * NMOD + j0 + ln];
#pragma unroll
                for (int w = 0; w < 8; ++w) s += red[(w * 9 + r) * 64 + ln];
                ((float*)(F.ws + WS_MOD))[(size_t)(l * 9 + r) * NMOD + j0 + ln] = s; }
            __syncthreads();
        }
    }
    __syncthreads();
    LAS float* scr = (LAS float*)(F.lds + 55296 + F.wave * 8448);
    constexpr int I_P = (256 / 64) * (256 / 32);
    constexpr int I_F1 = (D / 64) * (NFF / 32);
    constexpr int NIT = 4 * I_P + I_F1;
    for (int it = F.gw; it < NIT; it += F.NGW) {
        int r = it;
        if (r < 4 * I_P) { const int g = r / I_P; transpose_item(F.in[I_POOLW] + (size_t)g * 256 * 256, 256, 256, (bf16_t*)(F.ws + WS_WP), g * 256, scr, r % I_P, F.lane); continue; } r -= 4 * I_P;
        transpose_item(F.in[I_FWIN], D, NFF, (bf16_t*)(F.ws + WS_WF1), 0, scr, r, F.lane);
    }
}

__device__ __forceinline__ void ph_pool(Frame& F) {
    LAS float* hbuf = (LAS float*)(F.lds);
    LAS float* rs = (LAS float*)(F.lds + 80 * 256 * 4);
    bf16_t* YP = (bf16_t*)(F.ws + WS_H);
    const float* g0 = F.in[I_NORMG];
    for (int ti = F.vcu; ti < 288; ti += F.G) {
        int R0, W, p0, mrow;
        if (ti < 256) { R0 = ti * 64; W = 64; p0 = 0; mrow = ti >> 5; }
        else { const int cb = (ti - 256) >> 2, seg = (ti - 256) & 3; R0 = MX + cb * 256; W = 256; p0 = seg * 64; mrow = 8; }
        const int ps = p0 - 8 > 0 ? p0 - 8 : 0, pe = p0 + 72 < W ? p0 + 72 : W, nl = pe - ps;
        for (int i = F.wave; i < nl; i += NWAVES) { f32x4 v[4]; ld_row(src_row(F, R0 + ps + i), F.lane, v); const float ss = wave_sum(sumsq(v)); if (F.lane == 0) rs[i] = rsqrtf(ss * (1.f / D) + EPS); }
        __syncthreads();
        const float* sc = modp(F, 0, mrow, 1); const float* sh = modp(F, 0, mrow, 0);
        for (int gi = 0; gi < 4; ++gi) {
            { const int c4 = (F.tid & 63) * 4, cg = gi * 256 + c4;
              const f32x4 gv = *(const f32x4*)(g0 + cg), scv = *(const f32x4*)(sc + cg), shv = *(const f32x4*)(sh + cg);
              for (int i = F.tid >> 6; i < nl; i += 8) { const f32x4 xv = *(const f32x4*)(src_row(F, R0 + ps + i) + cg); const float r = rs[i];
                  *(LAS f32x4*)(hbuf + i * 256 + c4) = xv * r * gv * (scv + 1.f) + shv; } }
            __syncthreads();
            { const int c2 = (F.tid & 127) * 2, q = F.tid >> 7; const int win = 2 << gi;
              for (int pp = 0; pp < 16; ++pp) { const int p = p0 + q * 16 + pp;
                  int lo = p - win / 2; lo = lo < 0 ? 0 : lo; int hi = p - win / 2 + win; hi = hi > W ? W : hi;
                  float s0 = 0.f, s1 = 0.f;
                  for (int s = lo; s < hi; ++s) { const f32x2 hv = *(const LAS f32x2*)(hbuf + (s - ps) * 256 + c2); s0 += hv.x; s1 += hv.y; }
                  const float inv = 1.f / (float)(hi - lo); const f32x2 hc = *(const LAS f32x2*)(hbuf + (p - ps) * 256 + c2);
                  *(unsigned*)(YP + (size_t)(R0 + p) * D + gi * 256 + c2) = pk2(s0 * inv - hc.x, s1 * inv - hc.y); } }
            __syncthreads();
        }
    }
}

__device__ __forceinline__ void resid_row(const Frame& F, int r, const f32x4 (&y)[4], const float* xin, const float* gy, const float* gate,
                                          float* xout, const float* g2, const float* sc2, const float* sh2, bf16_t* hout) {
    const float rstd = rsqrtf(wave_sum(sumsq(y)) * (1.f / D) + EPS);
    f32x4 xv[4], gv[4], gt[4];
    ld_row(xin, F.lane, xv); ld_row(gy, F.lane, gv); ld_row(gate, F.lane, gt);
#pragma unroll
    for (int j = 0; j < 4; ++j) xv[j] = xv[j] + gt[j] * (y[j] * rstd * gv[j]);
    st_row(xout, F.lane, xv);
    if (hout) { const float rstd2 = rsqrtf(wave_sum(sumsq(xv)) * (1.f / D) + EPS); modulate_row_bf(xv, rstd2, g2, sc2, sh2, F.lane, hout); }
}

__device__ __forceinline__ void ph_e2(Frame& F) {
    const float* Y = (const float*)(F.ws + WS_Y0); bf16_t* H = (bf16_t*)(F.ws + WS_H);
    const float* ng = F.in[I_NORMG];
    for (int r = F.gw; r < MT; r += F.NGW) {
        const int mr = mrow_of(r);
        f32x4 y[4], ps[4]; ld_row(Y + (size_t)r * D, F.lane, y); ld_row(F.in[I_POOLS], F.lane, ps);
#pragma unroll
        for (int j = 0; j < 4; ++j) y[j] = y[j] * ps[j];
        resid_row(F, r, y, src_row(F, r), ng + 1 * D, modp(F, 0, mr, 2), stream_row(F, r), ng + 2 * D, modp(F, 0, mr, 4), modp(F, 0, mr, 3), H + (size_t)r * D);
    }
}
__device__ __forceinline__ void ph_e4(Frame& F) {
    bf16_t* H = (bf16_t*)(F.ws + WS_H);
    const float* ng = F.in[I_NORMG];
    for (int r = F.gw; r < MT; r += F.NGW) {
        const int mr = mrow_of(r);
        f32x4 y[4]; ld_row_bf(H + (size_t)r * D, F.lane, y);
        resid_row(F, r, y, stream_row(F, r), ng + 3 * D, modp(F, 0, mr, 5), stream_row(F, r), ng + 4 * D, modp(F, 1, mr, 1), modp(F, 1, mr, 0), H + (size_t)r * D);
    }
    LAS float* scr = (LAS float*)(F.lds + F.wave * 8448);
    constexpr int I_WI = (D / 64) * (INW / 32), I_WO = (D / 64) * (D / 32), I_F1 = (D / 64) * (NFF / 32), I_F2 = (DFF / 64) * (D / 32), I_ZP = (INWP - INW);
    constexpr int NIT = I_WI + I_WO + I_F1 + I_F2 + I_ZP;
    for (int it = F.gw; it < NIT; it += F.NGW) {
        int r = it;
        if (r < I_WI) { transpose_item(F.in[I_MWIN], D, INW, (bf16_t*)(F.ws + WS_WI), 0, scr, r, F.lane); continue; } r -= I_WI;
        if (r < I_WO) { transpose_item(F.in[I_MWOUT], D, D, (bf16_t*)(F.ws + WS_WO), 0, scr, r, F.lane); continue; } r -= I_WO;
        if (r < I_F1) { transpose_item(F.in[I_FWIN] + (size_t)D * NFF, D, NFF, (bf16_t*)(F.ws + WS_WF1), 0, scr, r, F.lane); continue; } r -= I_F1;
        if (r < I_F2) { transpose_item(F.in[I_FWOUT] + (size_t)DFF * D, DFF, D, (bf16_t*)(F.ws + WS_WF2B), 0, scr, r, F.lane); continue; } r -= I_F2;
        { u32x4* row = (u32x4*)((bf16_t*)(F.ws + WS_WI) + (size_t)(INW + r) * D); row[F.lane] = (u32x4){0u, 0u, 0u, 0u}; row[64 + F.lane] = (u32x4){0u, 0u, 0u, 0u}; }
    }
}
__device__ __forceinline__ void ph_e7(Frame& F) {
    const float* Y = (const float*)(F.ws + WS_Y1); bf16_t* H = (bf16_t*)(F.ws + WS_H);
    const float* ng = F.in[I_NORMG] + 4 * D;
    for (int r = F.gw; r < MX; r += F.NGW) {
        const int mr = r >> 11;
        f32x4 y[4]; ld_row(Y + (size_t)r * D, F.lane, y);
        resid_row(F, r, y, F.out + (size_t)r * D, ng + 1 * D, modp(F, 1, mr, 2), F.out + (size_t)r * D, ng + 2 * D, modp(F, 1, mr, 4), modp(F, 1, mr, 3), H + (size_t)r * D);
    }
}
__device__ __forceinline__ void ph_e9(Frame& F) {
    const bf16_t* FX = (const bf16_t*)(F.ws + WS_H);
    const float* ng = F.in[I_NORMG] + 4 * D;
    for (int r = F.gw; r < MX; r += F.NGW) {
        const int mr = r >> 11;
        f32x4 y[4]; ld_row_bf(FX + (size_t)r * D, F.lane, y);
        resid_row(F, r, y, F.out + (size_t)r * D, ng + 3 * D, modp(F, 1, mr, 5), F.out + (size_t)r * D, nullptr, nullptr, nullptr, nullptr);
    }
}

__device__ __forceinline__ void conv8(const bf16_t* src, int sld, int r, int c, const float* w, int wld, float (&acc)[8]) {
    int a_lo, a_hi, jj, Wd;
    if (r < MX) { const int n = r & (SEQ - 1), i = n >> 6; jj = n & 63; Wd = 64; a_lo = i > 0 ? 0 : 1; a_hi = i < 31 ? 2 : 1; }
    else { jj = (r - MX) & 255; Wd = 256; a_lo = 1; a_hi = 1; }
    const int b_lo = jj > 0 ? 0 : 1, b_hi = jj < Wd - 1 ? 2 : 1;
    for (int a = a_lo; a <= a_hi; ++a)
        for (int b = b_lo; b <= b_hi; ++b) {
            const int rn = r + (a - 1) * 64 + (b - 1);
            const u32x4 gv = *(const u32x4*)(src + (size_t)rn * sld + c);
            const float* wp = w + (a * 3 + b) * wld + c; const f32x4 w0 = *(const f32x4*)wp, w1 = *(const f32x4*)(wp + 4);
            acc[0] += bflo(gv.x) * w0[0]; acc[1] += bfhi(gv.x) * w0[1]; acc[2] += bflo(gv.y) * w0[2]; acc[3] += bfhi(gv.y) * w0[3];
            acc[4] += bflo(gv.z) * w1[0]; acc[5] += bfhi(gv.z) * w1[1]; acc[6] += bflo(gv.w) * w1[2]; acc[7] += bfhi(gv.w) * w1[3];
        }
}
__device__ __forceinline__ void ph_ffn_conv(Frame& F, bf16_t* UG, int M, int layer) {
    const float* cw = F.in[I_FCW] + (size_t)layer * 9 * DFF; const float* cb = F.in[I_FCB] + (size_t)layer * DFF;
    const int ntask = M * (DFF / 8);
    for (int t = F.vcu * NTHREADS + F.tid; t < ntask; t += F.G * NTHREADS) {
        const int r = t / (DFF / 8), c = (t % (DFF / 8)) * 8;
        float acc[8];
        { const f32x4 b0 = *(const f32x4*)(cb + c), b1 = *(const f32x4*)(cb + c + 4); acc[0] = b0[0]; acc[1] = b0[1]; acc[2] = b0[2]; acc[3] = b0[3]; acc[4] = b1[0]; acc[5] = b1[1]; acc[6] = b1[2]; acc[7] = b1[3]; }
        conv8(UG + DFF, NFF, r, c, cw, DFF, acc);
        u32x4* up = (u32x4*)(UG + (size_t)r * NFF + c); const u32x4 uv = *up;
        u32x4 o;
        o.x = pk2(silu_f(acc[0]) * bflo(uv.x), silu_f(acc[1]) * bfhi(uv.x)); o.y = pk2(silu_f(acc[2]) * bflo(uv.y), silu_f(acc[3]) * bfhi(uv.y));
        o.z = pk2(silu_f(acc[4]) * bflo(uv.z), silu_f(acc[5]) * bfhi(uv.z)); o.w = pk2(silu_f(acc[6]) * bflo(uv.w), silu_f(acc[7]) * bfhi(uv.w));
        *up = o;
    }
}
__device__ __forceinline__ void ph_e3(Frame& F) {
    ph_ffn_conv(F, (bf16_t*)(F.ws + WS_UG0), MT, 0);
    LAS float* scr = (LAS float*)(F.lds + F.wave * 8448);
    constexpr int I_F2 = (DFF / 64) * (D / 32);
    for (int it = F.gw; it < I_F2; it += F.NGW) transpose_item(F.in[I_FWOUT], DFF, D, (bf16_t*)(F.ws + WS_WF2A), 0, scr, it, F.lane);
}
__device__ __forceinline__ void ph_e5(Frame& F) {
    const bf16_t* Z = (const bf16_t*)(F.ws + WS_Z); bf16_t* QK = (bf16_t*)(F.ws + WS_H); float* GT = (float*)(F.ws + WS_GT);
    const float* cw = F.in[I_MCW]; const float* cb = F.in[I_MCB];
    const int ntask = MT * 128;
    for (int t = F.vcu * NTHREADS + F.tid; t < ntask; t += F.G * NTHREADS) {
        const int r = t >> 7, c = (t & 127) * 8;
        float acc[8];
        { const f32x4 b0 = *(const f32x4*)(cb + c), b1 = *(const f32x4*)(cb + c + 4); acc[0] = b0[0]; acc[1] = b0[1]; acc[2] = b0[2]; acc[3] = b0[3]; acc[4] = b1[0]; acc[5] = b1[1]; acc[6] = b1[2]; acc[7] = b1[3]; }
        conv8(Z, ZW, r, c, cw, D, acc);
        const float s = c >= 512 ? 0.125f : 1.f;
        u32x4 o;
        o.x = pk2(silu_f(acc[0]) * s, silu_f(acc[1]) * s); o.y = pk2(silu_f(acc[2]) * s, silu_f(acc[3]) * s);
        o.z = pk2(silu_f(acc[4]) * s, silu_f(acc[5]) * s); o.w = pk2(silu_f(acc[6]) * s, silu_f(acc[7]) * s);
        *(u32x4*)(QK + (size_t)r * D + c) = o;
    }
    for (int t = F.vcu * NTHREADS + F.tid; t < MT * 32; t += F.G * NTHREADS) {
        const int j = t & 31; float v = GT[t] + F.in[I_MBG][j];
        if (j >= 16) v = logsigmoid_f(v);
        GT[t] = v;
    }
}
__device__ __forceinline__ void ph_e6(Frame& F) {
    const bf16_t* Z = (const bf16_t*)(F.ws + WS_Z); bf16_t* HF = (bf16_t*)(F.ws + WS_HF); const bf16_t* HB = (const bf16_t*)(F.ws + WS_HB);
    for (int t = F.vcu * NTHREADS + F.tid; t < MX * 128; t += F.G * NTHREADS) {
        const int r = t >> 7, c = (t & 127) * 8;
        const u32x4 ov = *(const u32x4*)(Z + (size_t)r * ZW + 2048 + c), a = *(const u32x4*)(HF + (size_t)r * D + c), b = *(const u32x4*)(HB + (size_t)r * D + c);
        u32x4 o;
        o.x = pk2(sigmoid_f(bflo(ov.x)) * (bflo(a.x) + bflo(b.x)), sigmoid_f(bfhi(ov.x)) * (bfhi(a.x) + bfhi(b.x)));
        o.y = pk2(sigmoid_f(bflo(ov.y)) * (bflo(a.y) + bflo(b.y)), sigmoid_f(bfhi(ov.y)) * (bfhi(a.y) + bfhi(b.y)));
        o.z = pk2(sigmoid_f(bflo(ov.z)) * (bflo(a.z) + bflo(b.z)), sigmoid_f(bfhi(ov.z)) * (bfhi(a.z) + bfhi(b.z)));
        o.w = pk2(sigmoid_f(bflo(ov.w)) * (bflo(a.w) + bflo(b.w)), sigmoid_f(bfhi(ov.w)) * (bfhi(a.w) + bfhi(b.w)));
        *(u32x4*)(HF + (size_t)r * D + c) = o;
    }
}

#ifndef USE_MFMA_GEMM
#define USE_MFMA_GEMM 1
#endif
template <class Epi, bool ALIGN>
__device__ __forceinline__ void run_gemm(Frame& F, const bf16_t* A, const bf16_t* Bt, int M, int N, int K, int lda, int ldb, int akoff, const Epi& E) {
    pg8::Gemm g{A, Bt, M, N, K, lda, ldb, akoff}; pg8::StaticOrder S; S.init(M, N, F.G, (int)blockIdx.x);
    pg8::gemm_phase<Epi, pg8::StaticOrder, ALIGN>(F.lds + RING_OFF, g, S, E);
}

__global__ void __launch_bounds__(NTHREADS, 2) mega(P args) {
    extern __shared__ __attribute__((aligned(16))) unsigned char lds[];
    Frame F;
    F.lds = (LAS unsigned char*)lds;
    F.tid = threadIdx.x; F.lane = F.tid & 63; F.wave = __builtin_amdgcn_readfirstlane(F.tid >> 6);
    F.G = gridDim.x; { const int bx = blockIdx.x; F.vcu = (F.G % 8 == 0) ? (bx % 8) * (F.G / 8) + bx / 8 : bx; }
    F.gw = F.vcu * NWAVES + F.wave; F.NGW = F.G * NWAVES;
#pragma unroll
    for (int i = 0; i < 18; ++i) F.in[i] = args.in[i];
    F.out = args.out; F.ws = args.ws;
    volatile LAS unsigned* MISC = (volatile LAS unsigned*)(F.lds + MISC_OFF);
    for (int u = F.tid; u < (LDS_BYTES - LDSCTL_OFF) / 4; u += NTHREADS) ((LAS unsigned*)(F.lds + LDSCTL_OFF))[u] = 0u;
    __syncthreads();
    const int lo = args.lo, hi = args.hi;
    XcdBarrier bar; bar.bar = (unsigned*)(F.ws + WS_CTL) + CW_BAR; bar.x = 0; bar.st = nullptr;
    if (hi - lo > 1) bar = xcd_barrier_post((unsigned*)(F.ws + WS_CTL) + CW_BAR, MISC + 8);
#define IN(k) (lo <= (k) && (k) < hi)
#define SEAM(k) do { if (IN(k) && IN((k) + 1)) xcd_barrier(bar); } while (0)
    unsigned char* ws = F.ws;
    if (IN(PH_P0)) { ph_p0(F); } SEAM(PH_P0);
    if (IN(PH_POOL)) { ph_pool(F); } SEAM(PH_POOL);
    if (IN(PH_G1)) { pg8::EpiF32 E{(float*)(ws + WS_Y0), D}; run_gemm<pg8::EpiF32, true>(F, (const bf16_t*)(ws + WS_H), (const bf16_t*)(ws + WS_WP), MT, D, 256, D, 256, 256, E); } SEAM(PH_G1);
    if (IN(PH_E2)) { ph_e2(F); } SEAM(PH_E2);
    if (IN(PH_G2)) { pg8::EpiBf16 E{(bf16_t*)(ws + WS_UG0), NFF}; run_gemm<pg8::EpiBf16, true>(F, (const bf16_t*)(ws + WS_H), (const bf16_t*)(ws + WS_WF1), MT, NFF, D, D, D, 0, E); } SEAM(PH_G2);
    if (IN(PH_E3)) { ph_e3(F); } SEAM(PH_E3);
    if (IN(PH_G3)) { pg8::EpiBf16 E{(bf16_t*)(ws + WS_H), D}; run_gemm<pg8::EpiBf16, true>(F, (const bf16_t*)(ws + WS_UG0), (const bf16_t*)(ws + WS_WF2A), MT, D, DFF, NFF, DFF, 0, E); } SEAM(PH_G3);
    if (IN(PH_E4)) { ph_e4(F); } SEAM(PH_E4);
    if (IN(PH_G4)) { pg8::EpiZ E{(bf16_t*)(ws + WS_Z), (float*)(ws + WS_GT)}; run_gemm<pg8::EpiZ, true>(F, (const bf16_t*)(ws + WS_H), (const bf16_t*)(ws + WS_WI), MT, INWP, D, D, D, 0, E); } SEAM(PH_G4);
    if (IN(PH_E5)) { ph_e5(F); } SEAM(PH_E5);
      SEAM(PH_MLSTM);
    if (IN(PH_E6)) { ph_e6(F); } SEAM(PH_E6);
    if (IN(PH_G5)) { pg8::EpiF32 E{(float*)(ws + WS_Y1), D}; run_gemm<pg8::EpiF32, true>(F, (const bf16_t*)(ws + WS_HF), (const bf16_t*)(ws + WS_WO), MX, D, D, D, D, 0, E); } SEAM(PH_G5);
    if (IN(PH_E7)) { ph_e7(F); } SEAM(PH_E7);
    if (IN(PH_G6)) { pg8::EpiBf16 E{(bf16_t*)(ws + WS_UG1), NFF}; run_gemm<pg8::EpiBf16, true>(F, (const bf16_t*)(ws + WS_H), (const bf16_t*)(ws + WS_WF1), MX, NFF, D, D, D, 0, E); } SEAM(PH_G6);
    if (IN(PH_E8)) { ph_ffn_conv(F, (bf16_t*)(ws + WS_UG1), MX, 1); } SEAM(PH_E8);
    if (IN(PH_G7)) { pg8::EpiBf16 E{(bf16_t*)(ws + WS_H), D}; run_gemm<pg8::EpiBf16, true>(F, (const bf16_t*)(ws + WS_UG1), (const bf16_t*)(ws + WS_WF2B), MX, D, DFF, NFF, DFF, 0, E); } SEAM(PH_G7);
    if (IN(PH_E9)) { ph_e9(F); }
#undef IN
#undef SEAM
}

__global__ void __launch_bounds__(256) k_gemm_naive(const bf16_t* A, const bf16_t* Bt, int K, int lda, int ldb, int akoff, int mode, void* O, int ldc, float* GT) {
    __shared__ float As[16][65], Bs[16][65];
    const int n0 = blockIdx.x * 64, m0 = blockIdx.y * 64, tx = threadIdx.x & 15, ty = threadIdx.x >> 4;
    const bf16_t* Ab = A + (size_t)(n0 / 256) * akoff;
    float acc[4][4];
#pragma unroll
    for (int i = 0; i < 4; ++i)
#pragma unroll
        for (int j = 0; j < 4; ++j) acc[i][j] = 0.f;
    for (int k0 = 0; k0 < K; k0 += 16) {
        for (int i = threadIdx.x; i < 64 * 16; i += 256) { const int rr = i >> 4, kk = i & 15; As[kk][rr] = bf2f(Ab[(size_t)(m0 + rr) * lda + k0 + kk]); Bs[kk][rr] = bf2f(Bt[(size_t)(n0 + rr) * ldb + k0 + kk]); }
        __syncthreads();
#pragma unroll
        for (int kk = 0; kk < 16; ++kk) {
            float a[4], b[4];
#pragma unroll
            for (int i = 0; i < 4; ++i) { a[i] = As[kk][ty * 4 + i]; b[i] = Bs[kk][tx * 4 + i]; }
#pragma unroll
            for (int i = 0; i < 4; ++i)
#pragma unroll
                for (int j = 0; j < 4; ++j) acc[i][j] += a[i] * b[j];
        }
        __syncthreads();
    }
#pragma unroll
    for (int i = 0; i < 4; ++i)
#pragma unroll
        for (int j = 0; j < 4; ++j) {
            const int r = m0 + ty * 4 + i, c = n0 + tx * 4 + j;
            if (mode == 0) ((float*)O)[(size_t)r * ldc + c] = acc[i][j];
            else if (mode == 1) ((bf16_t*)O)[(size_t)r * ldc + c] = (bf16_t)f2bf(acc[i][j]);
            else { if (c < ZW) ((bf16_t*)O)[(size_t)r * ZW + c] = (bf16_t)f2bf(acc[i][j]); else if (c < ZW + 32) GT[(size_t)r * 32 + (c - ZW)] = acc[i][j]; }
        }
}
__global__ void __launch_bounds__(128) k_mlstm_naive(const bf16_t* QK, const bf16_t* Z, const float* GT, bf16_t* HF, bf16_t* HB) {
    const int bid = blockIdx.x, dir = bid & 1, h = (bid >> 1) & 7, b = bid >> 4, v = threadIdx.x;
    __shared__ float sq[64], sk[64];
    float C[64], n[64];
#pragma unroll
    for (int j = 0; j < 64; ++j) { C[j] = 0.f; n[j] = 0.f; }
    float m = 0.f;
    for (int s = 0; s < CTXL + SEQ; ++s) {
        int r;
        if (s < CTXL) { const int j = dir ? CTXL - 1 - s : s; r = MX + b * CTXL + j; } else { int j = s - CTXL; if (dir) j = SEQ - 1 - j; r = b * SEQ + j; }
        if (v < 64) sq[v] = bf2f(QK[(size_t)r * D + h * 64 + v]); else sk[v - 64] = bf2f(QK[(size_t)r * D + 512 + h * 64 + (v - 64)]);
        const float vv = bf2f(Z[(size_t)r * ZW + 1024 + h * 128 + v]);
        const float ig = GT[(size_t)r * 32 + dir * 8 + h], lf = GT[(size_t)r * 32 + 16 + dir * 8 + h];
        __syncthreads();
        const float mn = fmaxf(lf + m, ig), fa = __expf(lf + m - mn), fi = __expf(ig - mn);
        float num = 0.f, den = 0.f;
#pragma unroll
        for (int j = 0; j < 64; ++j) { const float kj = sk[j]; C[j] = fa * C[j] + fi * kj * vv; n[j] = fa * n[j] + fi * kj; num += sq[j] * C[j]; den += sq[j] * n[j]; }
        m = mn;
        if (s >= CTXL) { const float hh = num / fmaxf(fabsf(den), __expf(-mn)); (dir ? HB : HF)[(size_t)r * D + h * 128 + v] = (bf16_t)f2bf(hh); }
        __syncthreads();
    }
}

static void launch_naive_gemm(hipStream_t s, const bf16_t* A, const bf16_t* Bt, int M, int N, int K, int lda, int ldb, int akoff, int mode, void* O, int ldc, float* GT) {
    hipLaunchKernelGGL(k_gemm_naive, dim3(N / 64, M / 64), dim3(256), 0, s, A, Bt, K, lda, ldb, akoff, mode, O, ldc, GT);
}
extern "C" void kernel_launch(void* const* d_in, const int* in_sizes, int n_in, void* d_out, int out_size, void* d_ws, size_t ws_size, hipStream_t stream) {
    static int grid = 0;
    if (grid == 0) {
        if (n_in != 18 || out_size != MX * D || ws_size < WS_END) { fprintf(stderr, "kernel_launch: unexpected shapes n_in %d out %d ws %zu\n", n_in, out_size, ws_size); grid = -1; return; }
        int dev = 0, cus = 0, per_cu = 0;
        (void)hipGetDevice(&dev); (void)hipDeviceGetAttribute(&cus, hipDeviceAttributeMultiprocessorCount, dev);
        (void)hipFuncSetAttribute((const void*)mega, hipFuncAttributeMaxDynamicSharedMemorySize, LDS_BYTES);
        (void)hipOccupancyMaxActiveBlocksPerMultiprocessor(&per_cu, (const void*)mega, NTHREADS, LDS_BYTES);
        (void)hipGetLastError();
        if (per_cu < 1) fprintf(stderr, "kernel_launch: occupancy query says %d blocks/CU\n", per_cu);
        grid = cus;
    }
    if (grid < 0) return;
    (void)hipMemsetAsync((char*)d_ws + WS_CTL, 0, CTL_ZERO_BYTES, stream);
    P a{};
    for (int i = 0; i < 18; ++i) a.in[i] = (const float*)d_in[i];
    a.out = (float*)d_out; a.ws = (unsigned char*)d_ws;
    unsigned char* ws = (unsigned char*)d_ws;
    for (int ph = 0; ph < NPH; ++ph) {
        if (ph == PH_MLSTM) {
            hipLaunchKernelGGL(k_mlstm_naive, dim3(128), dim3(128), 0, stream, (const bf16_t*)(ws + WS_H), (const bf16_t*)(ws + WS_Z), (const float*)(ws + WS_GT), (bf16_t*)(ws + WS_HF), (bf16_t*)(ws + WS_HB));
            continue;
        }
#if !USE_MFMA_GEMM
        if (ph == PH_G1) { launch_naive_gemm(stream, (const bf16_t*)(ws + WS_H), (const bf16_t*)(ws + WS_WP), MT, D, 256, D, 256, 256, 0, ws + WS_Y0, D, nullptr); continue; }
        if (ph == PH_G2) { launch_naive_gemm(stream, (const bf16_t*)(ws + WS_H), (const bf16_t*)(ws + WS_WF1), MT, NFF, D, D, D, 0, 1, ws + WS_UG0, NFF, nullptr); continue; }
        if (ph == PH_G3) { launch_naive_gemm(stream, (const bf16_t*)(ws + WS_UG0), (const bf16_t*)(ws + WS_WF2A), MT, D, DFF, NFF, DFF, 0, 1, ws + WS_H, D, nullptr); continue; }
        if (ph == PH_G4) { launch_naive_gemm(stream, (const bf16_t*)(ws + WS_H), (const bf16_t*)(ws + WS_WI), MT, INWP, D, D, D, 0, 2, ws + WS_Z, ZW, (float*)(ws + WS_GT)); continue; }
        if (ph == PH_G5) { launch_naive_gemm(stream, (const bf16_t*)(ws + WS_HF), (const bf16_t*)(ws + WS_WO), MX, D, D, D, D, 0, 0, ws + WS_Y1, D, nullptr); continue; }
        if (ph == PH_G6) { launch_naive_gemm(stream, (const bf16_t*)(ws + WS_H), (const bf16_t*)(ws + WS_WF1), MX, NFF, D, D, D, 0, 1, ws + WS_UG1, NFF, nullptr); continue; }
        if (ph == PH_G7) { launch_naive_gemm(stream, (const bf16_t*)(ws + WS_UG1), (const bf16_t*)(ws + WS_WF2B), MX, D, DFF, NFF, DFF, 0, 1, ws + WS_H, D, nullptr); continue; }
#endif
        a.lo = ph; a.hi = ph + 1;
        hipLaunchKernelGGL(mega, dim3(grid), dim3(NTHREADS), LDS_BYTES, stream, a);
    }
}
```

```cpp
#include <hip/hip_runtime.h>
#include <cstdio>
#include <cstdint>

#define LAS __attribute__((address_space(3)))
typedef unsigned short bf16_t;
typedef short bf16x8 __attribute__((ext_vector_type(8)));
typedef float f32x4 __attribute__((ext_vector_type(4)));
typedef float f32x2 __attribute__((ext_vector_type(2)));
typedef unsigned u32x4 __attribute__((ext_vector_type(4)));
typedef unsigned u32x2 __attribute__((ext_vector_type(2)));

constexpr int D = 1024, NB = 8, SEQ = 2048, CTXL = 256, GWID = 64;
constexpr int MX = NB * SEQ, MC = NB * CTXL, MT = MX + MC;
constexpr int DFF = 2816, NFF = 2 * DFF;
constexpr int NH = 8, INW = 3104, INWP = 3328, ZW = 3072;
constexpr int NMOD = 6 * D;
constexpr float EPS = 1e-6f;
constexpr int NWAVES = 8, NTHREADS = 512;

constexpr size_t MiB = 1u << 20;
constexpr size_t WS_CTL = 0, CTL_ZERO_BYTES = 64 * 1024;
constexpr size_t WS_MOD = 1 * MiB;
constexpr size_t WS_XC = 2 * MiB;
constexpr size_t WS_WP = 10 * MiB;
constexpr size_t WS_WF1 = 11 * MiB;
constexpr size_t WS_WF2A = 11 * MiB;
constexpr size_t WS_H = 22 * MiB;
constexpr size_t WS_BIG = 58 * MiB;
constexpr size_t WS_UG0 = 58 * MiB;
constexpr size_t WS_Y0 = 58 * MiB;
constexpr size_t WS_WI = 58 * MiB;
constexpr size_t WS_WO = 65 * MiB;
constexpr size_t WS_WF2B = 67 * MiB;
constexpr size_t WS_Z = 73 * MiB;
constexpr size_t WS_Y1 = 73 * MiB;
constexpr size_t WS_GT = 181 * MiB;
constexpr size_t WS_HF = 187 * MiB;
constexpr size_t WS_HB = 219 * MiB;
constexpr size_t WS_UG1 = 80 * MiB;
constexpr size_t WS_END = 256 * MiB;
static_assert(WS_UG0 + (size_t)MT * NFF * 2 <= WS_END, "ug0");
static_assert(WS_UG1 + (size_t)MX * NFF * 2 <= WS_END, "ug1");
static_assert(WS_HB + (size_t)MX * D * 2 <= WS_END, "hb");
static_assert(WS_H + (size_t)MT * D * 2 <= WS_BIG, "h");
static_assert(WS_Z + (size_t)MT * ZW * 2 <= WS_GT, "z");
static_assert(WS_GT + (size_t)MT * 32 * 4 <= WS_HF, "gt");

enum { PH_P0 = 0, PH_POOL, PH_G1, PH_E2, PH_G2, PH_E3, PH_G3, PH_E4, PH_G4, PH_E5, PH_MLSTM, PH_E6, PH_G5, PH_E7, PH_G6, PH_E8, PH_G7, PH_E9, NPH };

struct P {
    const float* in[18];
    float* out;
    unsigned char* ws;
    int lo, hi;
};
enum { I_X = 0, I_C, I_CTX, I_CCTX, I_MODW, I_MODB, I_NORMG, I_POOLW, I_POOLS, I_MWIN, I_MBG, I_MCW, I_MCB, I_MWOUT, I_FWIN, I_FCW, I_FCB, I_FWOUT };

__device__ __forceinline__ unsigned f2bf(float f) { unsigned u = __builtin_bit_cast(unsigned, f); return (u + 0x7fffu + ((u >> 16) & 1u)) >> 16; }
__device__ __forceinline__ unsigned pk2(float lo, float hi) { return f2bf(lo) | (f2bf(hi) << 16); }
__device__ __forceinline__ float bf2f(unsigned short h) { return __builtin_bit_cast(float, (unsigned)h << 16); }
__device__ __forceinline__ float bflo(unsigned w) { return __builtin_bit_cast(float, w << 16); }
__device__ __forceinline__ float bfhi(unsigned w) { return __builtin_bit_cast(float, w & 0xffff0000u); }
__device__ __forceinline__ float wave_sum(float v) {
#pragma unroll
    for (int o = 1; o < 64; o <<= 1) v += __shfl_xor(v, o);
    return v;
}
__device__ __forceinline__ float silu_f(float x) { return x / (1.f + __expf(-x)); }
__device__ __forceinline__ float sigmoid_f(float x) { return 1.f / (1.f + __expf(-x)); }
__device__ __forceinline__ float logsigmoid_f(float x) { return fminf(x, 0.f) - log1pf(__expf(-fabsf(x))); }
__device__ __forceinline__ int mrow_of(int r) { return r < MX ? (r >> 11) : 8; }
#define LDS_WAIT() asm volatile("s_waitcnt lgkmcnt(0)" ::: "memory")

namespace pg8 {
constexpr int BM = 256, BK = 64, HALF = 128, HTB = HALF * BK * 2, STAGE_BYTES = 8 * HTB, NXCD = 8, WGM = 8;
__host__ __device__ __forceinline__ int lds_byte(int r, int c) { const int st = (r >> 4) * 2 + (c >> 5), rr = r & 15, cc = c & 31, ob = rr * 64 + cc * 2; return st * 1024 + (ob ^ (((ob >> 9) & 1) << 5)); }
__host__ __device__ __forceinline__ void stage_rc(int b, int& R, int& C) { const int st = b / 1024, sb = b % 1024, swz = sb ^ (((sb >> 9) & 1) << 5); R = (st >> 1) * 16 + swz / 64; C = (st & 1) * 32 + (swz % 64) / 2; }
__host__ __device__ __forceinline__ int perm32(int rho) { const int n = rho >> 4, i = rho & 15; return 8 * (i >> 2) + 4 * n + (i & 3); }
struct Unit { int pm, pn; };
struct Gemm { const bf16_t* A; const bf16_t* Bt; int M, N, K, lda, ldb, akoff; };
struct StaticOrder {
    int nM, nN, nwg, G, c;
    __host__ __device__ void init(int M, int N, int G_, int c_) { nM = M / BM; nN = N / BM; nwg = nM * nN; G = G_; c = c_; }
    __host__ __device__ bool next(int i, Unit& u) const {
        const long L = (long)i * G + c; if (L >= nwg) return false;
        int wgid = (int)L; { const int q = nwg / NXCD, r = nwg % NXCD, xcd = wgid % NXCD, off = wgid / NXCD; wgid = (xcd < r ? xcd * (q + 1) : r * (q + 1) + (xcd - r) * q) + off; }
        const int nig = WGM * nN, gid = wgid / nig, fm = gid * WGM, gsz = (nM - fm) < WGM ? (nM - fm) : WGM;
        u.pm = fm + ((wgid % nig) % gsz); u.pn = (wgid % nig) / gsz; return true;
    }
};
__device__ __forceinline__ unsigned cvt_pk_bf16(float lo, float hi) { unsigned r; asm volatile("v_cvt_pk_bf16_f32 %0, %1, %2" : "=v"(r) : "v"(lo), "v"(hi)); return r; }

struct EpiF32 {
    static constexpr bool PERM = false;
    float* O; int ldc;
    __device__ __forceinline__ void operator()(const f32x4 (&acc)[2][2][4][2], const Unit& u, int wr, int wc, int fr, int fq) const {
        const int row0 = u.pm * BM + wr * 64 + fr, col0 = u.pn * BM + wc * 32 + 4 * fq;
#pragma unroll
        for (int ai = 0; ai < 2; ++ai)
#pragma unroll
            for (int m = 0; m < 4; ++m) { float* rowp = O + (size_t)(row0 + ai * HALF + m * 16) * ldc + col0;
#pragma unroll
                for (int bj = 0; bj < 2; ++bj)
#pragma unroll
                    for (int n = 0; n < 2; ++n) *(f32x4*)(rowp + bj * HALF + n * 16) = acc[ai][bj][m][n]; }
    }
};
struct EpiBf16 {
    static constexpr bool PERM = true;
    bf16_t* O; int ldc;
    __device__ __forceinline__ void operator()(const f32x4 (&acc)[2][2][4][2], const Unit& u, int wr, int wc, int fr, int fq) const {
        const int row0 = u.pm * BM + wr * 64 + fr, col0 = u.pn * BM + wc * 32 + 8 * fq;
#pragma unroll
        for (int ai = 0; ai < 2; ++ai)
#pragma unroll
            for (int m = 0; m < 4; ++m) { bf16_t* rowp = O + (size_t)(row0 + ai * HALF + m * 16) * ldc + col0;
#pragma unroll
                for (int bj = 0; bj < 2; ++bj) { const f32x4 v0 = acc[ai][bj][m][0], v1 = acc[ai][bj][m][1];
                    u32x4 w; w.x = cvt_pk_bf16(v0[0], v0[1]); w.y = cvt_pk_bf16(v0[2], v0[3]); w.z = cvt_pk_bf16(v1[0], v1[1]); w.w = cvt_pk_bf16(v1[2], v1[3]);
                    *(u32x4*)(rowp + bj * HALF) = w; } }
    }
};
struct EpiZ {
    static constexpr bool PERM = true;
    bf16_t* Z; float* GT;
    __device__ __forceinline__ void operator()(const f32x4 (&acc)[2][2][4][2], const Unit& u, int wr, int wc, int fr, int fq) const {
        const int row0 = u.pm * BM + wr * 64 + fr;
        if (u.pn < 12) {
            const int col0 = u.pn * BM + wc * 32 + 8 * fq;
#pragma unroll
            for (int ai = 0; ai < 2; ++ai)
#pragma unroll
                for (int m = 0; m < 4; ++m) { bf16_t* rowp = Z + (size_t)(row0 + ai * HALF + m * 16) * ZW + col0;
#pragma unroll
                    for (int bj = 0; bj < 2; ++bj) { const f32x4 v0 = acc[ai][bj][m][0], v1 = acc[ai][bj][m][1];
                        u32x4 w; w.x = cvt_pk_bf16(v0[0], v0[1]); w.y = cvt_pk_bf16(v0[2], v0[3]); w.z = cvt_pk_bf16(v1[0], v1[1]); w.w = cvt_pk_bf16(v1[2], v1[3]);
                        *(u32x4*)(rowp + bj * HALF) = w; } }
        } else if (wc == 0) {
#pragma unroll
            for (int ai = 0; ai < 2; ++ai)
#pragma unroll
                for (int m = 0; m < 4; ++m) { float* rowp = GT + (size_t)(row0 + ai * HALF + m * 16) * 32 + 8 * fq;
                    *(f32x4*)(rowp) = acc[ai][0][m][0]; *(f32x4*)(rowp + 4) = acc[ai][0][m][1]; }
        }
    }
};

template <class Epi, class Sched, bool ALIGN_EPI>
__device__ __forceinline__ void gemm_phase(LAS unsigned char* lds, const Gemm g, const Sched& S, const Epi& E) {
    const int tid = threadIdx.x, wid = __builtin_amdgcn_readfirstlane(tid >> 6), lane = tid & 63, wr = wid >> 2, wc = wid & 3, fr = lane & 15, fq = lane >> 4;
    const int K = g.K, nt = K / BK;
    unsigned voffA[2], voffB[2];
#pragma unroll
    for (int i = 0; i < 2; ++i) { int R, C; stage_rc(tid * 16 + i * 8192, R, C); const int Rb = Epi::PERM ? ((R & ~31) + perm32(R & 31)) : R;
        voffA[i] = (unsigned)(R * g.lda + C) * 2u; voffB[i] = (unsigned)(Rb * g.ldb + C) * 2u; }
    const size_t kstep = (size_t)(BK * 2);
    const size_t hstepA = (size_t)HALF * g.lda * 2, hstepB = (size_t)HALF * g.ldb * 2;
    const size_t tstepA = 2 * hstepA, tstepB = 2 * hstepB;
    const size_t akoffb = (size_t)g.akoff * 2;
    const unsigned ldsw = (unsigned)wid * 1024u;
    const int aoff = lds_byte(wr * 64 + fr, fq * 8), boff = lds_byte(wc * 32 + fr, fq * 8);
#define PG8_SA(b, h) (((b) * 2 + (h)) * HTB)
#define PG8_SB(b, h) ((4 + (b) * 2 + (h)) * HTB)
#define PG8_STAGE(bufoff, gbase, voff) do { _Pragma("unroll") for (int _i = 0; _i < 2; ++_i) \
        __builtin_amdgcn_global_load_lds((const unsigned*)((const char*)(gbase) + (voff)[_i]), (LAS unsigned*)(lds + (bufoff) + ldsw + _i * 8192), 16, 0, 0); } while (0)
#define PG8_LDA(dst, b, h) do { _Pragma("unroll") for (int m = 0; m < 4; ++m) _Pragma("unroll") for (int k = 0; k < 2; ++k) dst[m][k] = *(const LAS bf16x8*)(lds + PG8_SA(b, h) + aoff + m * 2048 + k * 1024); } while (0)
#define PG8_LDB(dst, b, h) do { _Pragma("unroll") for (int n = 0; n < 2; ++n) _Pragma("unroll") for (int k = 0; k < 2; ++k) dst[n][k] = *(const LAS bf16x8*)(lds + PG8_SB(b, h) + boff + n * 2048 + k * 1024); } while (0)
#define PG8_MMA(ai, bj, At, Bt) do { __builtin_amdgcn_s_setprio(1); _Pragma("unroll") for (int m = 0; m < 4; ++m) _Pragma("unroll") for (int n = 0; n < 2; ++n) _Pragma("unroll") for (int k = 0; k < 2; ++k) \
        acc[ai][bj][m][n] = __builtin_amdgcn_mfma_f32_16x16x32_bf16(Bt[n][k], At[m][k], acc[ai][bj][m][n], 0, 0, 0); __builtin_amdgcn_s_setprio(0); } while (0)
#define PG8_WAIT_V(n) asm volatile("s_waitcnt vmcnt(" #n ")" ::: "memory")
#define PG8_WAIT_L(n) asm volatile("s_waitcnt lgkmcnt(" #n ")" ::: "memory")
#define PG8_BAR __builtin_amdgcn_s_barrier()
#define PG8_SCHED __builtin_amdgcn_sched_barrier(0)
    Unit cur, nxt; int ui = 0;
    if (!S.next(0, cur)) return;
    f32x4 acc[2][2][4][2];
#pragma unroll
    for (int a = 0; a < 2; ++a)
#pragma unroll
        for (int b = 0; b < 2; ++b)
#pragma unroll
            for (int m = 0; m < 4; ++m)
#pragma unroll
                for (int n = 0; n < 2; ++n) acc[a][b][m][n] = (f32x4){0.f, 0.f, 0.f, 0.f};
    bf16x8 At[4][2], B0[2][2], B1[2][2];
    const char* cA = (const char*)g.A + (size_t)cur.pm * tstepA + (size_t)cur.pn * akoffb; const char* cB = (const char*)g.Bt + (size_t)cur.pn * tstepB;
    PG8_STAGE(PG8_SB(0, 0), cB, voffB); PG8_STAGE(PG8_SB(0, 1), cB + hstepB, voffB); PG8_STAGE(PG8_SA(0, 0), cA, voffA); PG8_STAGE(PG8_SA(0, 1), cA + hstepA, voffA);
    if (wr == 1) PG8_BAR;
    PG8_WAIT_V(2); PG8_BAR;
    PG8_STAGE(PG8_SB(1, 0), cB + kstep, voffB); PG8_STAGE(PG8_SA(1, 0), cA + kstep, voffA); PG8_STAGE(PG8_SB(1, 1), cB + hstepB + kstep, voffB);
    PG8_WAIT_V(6); PG8_BAR;
    for (;;) {
        const bool has_next = S.next(ui + 1, nxt);
        const char* nA = has_next ? (const char*)g.A + (size_t)nxt.pm * tstepA + (size_t)nxt.pn * akoffb : cA; const char* nB = has_next ? (const char*)g.Bt + (size_t)nxt.pn * tstepB : cB;
        for (int t = 0; t < nt; t += 2) {
            const bool last = (t == nt - 2);
            const char* a1 = cA + (size_t)(t + 1) * kstep;
            const char* a2 = last ? nA : cA + (size_t)(t + 2) * kstep; const char* b2 = last ? nB : cB + (size_t)(t + 2) * kstep;
            const char* a3 = a2 + kstep; const char* b3 = b2 + kstep;
            PG8_LDB(B0, 0, 0); PG8_LDB(B1, 0, 1); PG8_SCHED; PG8_LDA(At, 0, 0); PG8_STAGE(PG8_SA(1, 1), a1 + hstepA, voffA);
            PG8_WAIT_V(8); PG8_WAIT_L(0); PG8_BAR; PG8_MMA(0, 0, At, B0); PG8_MMA(0, 1, At, B1); PG8_BAR; PG8_SCHED;
            PG8_LDA(At, 0, 1); PG8_STAGE(PG8_SB(0, 0), b2, voffB); PG8_STAGE(PG8_SB(0, 1), b2 + hstepB, voffB); PG8_STAGE(PG8_SA(0, 0), a2, voffA);
            PG8_WAIT_V(8); PG8_WAIT_L(0); PG8_BAR; PG8_MMA(1, 0, At, B0); PG8_MMA(1, 1, At, B1); PG8_BAR; PG8_SCHED;
            PG8_LDB(B0, 1, 0); PG8_LDB(B1, 1, 1); PG8_SCHED; PG8_LDA(At, 1, 0); PG8_STAGE(PG8_SA(0, 1), a2 + hstepA, voffA);
            PG8_WAIT_V(8); PG8_WAIT_L(0); PG8_BAR; PG8_MMA(0, 0, At, B0); PG8_MMA(0, 1, At, B1); PG8_BAR; PG8_SCHED;
            PG8_LDA(At, 1, 1); PG8_STAGE(PG8_SB(1, 0), b3, voffB); PG8_STAGE(PG8_SB(1, 1), b3 + hstepB, voffB); PG8_STAGE(PG8_SA(1, 0), a3, voffA);
            PG8_WAIT_V(8); PG8_WAIT_L(0); PG8_BAR; PG8_MMA(1, 0, At, B0); PG8_MMA(1, 1, At, B1); PG8_BAR; PG8_SCHED;
        }
        if constexpr (ALIGN_EPI) { if (wr == 0) PG8_BAR; }
        E(acc, cur, wr, wc, fr, fq);
        if (!has_next) break;
#pragma unroll
        for (int a = 0; a < 2; ++a)
#pragma unroll
            for (int b = 0; b < 2; ++b)
#pragma unroll
                for (int m = 0; m < 4; ++m)
#pragma unroll
                    for (int n = 0; n < 2; ++n) acc[a][b][m][n] = (f32x4){0.f, 0.f, 0.f, 0.f};
        cur = nxt; cA = nA; cB = nB; ++ui;
        if constexpr (ALIGN_EPI) { if (wr == 1) PG8_BAR; }
    }
    PG8_WAIT_V(0);
    if constexpr (!ALIGN_EPI) { if (wr == 0) PG8_BAR; }
    PG8_BAR;
#undef PG8_SA
#undef PG8_SB
#undef PG8_STAGE
#undef PG8_LDA
#undef PG8_LDB
#undef PG8_MMA
#undef PG8_WAIT_V
#undef PG8_WAIT_L
#undef PG8_BAR
#undef PG8_SCHED
}
}

constexpr int RING_OFF = 0, RING_BYTES = 131072;
constexpr int LDSCTL_OFF = RING_BYTES, MISC_OFF = LDSCTL_OFF + 320;
constexpr int LDS_BYTES = 147456;
constexpr int CW_BAR = 4096;
#define XB_TMO      128
#define XB_XCNT(j)  (256  + 64 * (j))
#define XB_XSUB(j)  (1280 + 64 * (j))
#define XB_XGEN(j)  (2304 + 64 * (j))
#define XB_TOP      3328
#define XB_TOPGEN   3392
#define XCD_BAR_WORDS 3456
#define XB_SPIN_CAP (1u << 18)
__device__ __forceinline__ unsigned xb_ld(unsigned* p)              { return __hip_atomic_load(p, __ATOMIC_RELAXED, __HIP_MEMORY_SCOPE_AGENT); }
__device__ __forceinline__ unsigned xb_add(unsigned* p, unsigned v) { return __hip_atomic_fetch_add(p, v, __ATOMIC_RELAXED, __HIP_MEMORY_SCOPE_AGENT); }
__device__ __forceinline__ unsigned xb_xcc_id() { return (unsigned)__builtin_amdgcn_s_getreg((3 << 11) | 20) & 0xFu; }
#define XB_SPIN(cond, bar) do { unsigned _sp = 0; while (cond) { __builtin_amdgcn_s_sleep(1); \
    if ((++_sp & 255u) == 0u) { if (xb_ld(&(bar)[XB_TMO])) break; if (_sp > XB_SPIN_CAP) { atomicAdd(&(bar)[XB_TMO], 1u); break; } } } } while (0)
struct XcdBarrier { unsigned* bar; unsigned x; volatile LAS unsigned* st; };
__device__ __forceinline__ XcdBarrier xcd_barrier_post(unsigned* bar, volatile LAS unsigned* st) {
    XcdBarrier b; b.bar = bar; b.x = xb_xcc_id(); b.st = st;
    if (threadIdx.x == 0) (void)xb_add(&bar[XB_XCNT(b.x)], 1u);
    return b;
}
__device__ __forceinline__ void xcd_barrier_complete(unsigned* bar, unsigned x, unsigned& nloc, unsigned& nx) {
    const unsigned G = gridDim.x * gridDim.y * gridDim.z;
    unsigned sum, cnt, mine, sp = 0u;
    for (;;) {
        sum = 0u; cnt = 0u; mine = 0u;
#pragma unroll
        for (unsigned j = 0; j < 16; ++j) { const unsigned c = xb_ld(&bar[XB_XCNT(j)]); sum += c; cnt += (c > 0u) ? 1u : 0u; mine = (j == x) ? c : mine; }
        if (sum == G) break;
        __builtin_amdgcn_s_sleep(1);
        if ((++sp & 255u) == 0u) { if (xb_ld(&bar[XB_TMO])) break; if (sp > XB_SPIN_CAP) { atomicAdd(&bar[XB_TMO], 1u); break; } }
    }
    nloc = mine > 0u ? mine : 1u; nx = cnt > 0u ? cnt : 1u;
}
__device__ __forceinline__ void xcd_barrier(const XcdBarrier& b) {
    asm volatile("s_waitcnt vmcnt(0)" ::: "memory");
    __syncthreads();
    if (threadIdx.x == 0) {
        unsigned* bar = b.bar;
        __builtin_amdgcn_s_waitcnt(0);
        unsigned nloc = b.st[0], nx = b.st[1];
        if (nloc == 0u) { xcd_barrier_complete(bar, b.x, nloc, nx); b.st[0] = nloc; b.st[1] = nx; }
        const unsigned old = xb_add(&bar[XB_XSUB(b.x)], 1u);
        const unsigned gen = old / nloc;
        if (old + 1u == (gen + 1u) * nloc) {
            __builtin_amdgcn_fence(__ATOMIC_RELEASE, "agent");
            asm volatile("s_waitcnt vmcnt(0)" ::: "memory");
            const unsigned og = xb_add(&bar[XB_TOP], 1u);
            const unsigned tg = og / nx;
            if (og + 1u == (tg + 1u) * nx) xb_add(&bar[XB_TOPGEN], 1u);
            else XB_SPIN(xb_ld(&bar[XB_TOPGEN]) == tg, bar);
            __builtin_amdgcn_fence(__ATOMIC_ACQUIRE, "agent");
            xb_add(&bar[XB_XGEN(b.x)], 1u);
            asm volatile("s_waitcnt vmcnt(0)" ::: "memory");
        } else {
            XB_SPIN(xb_ld(&bar[XB_XGEN(b.x)]) == gen, bar);
            __builtin_amdgcn_fence(__ATOMIC_ACQUIRE, "agent");
            asm volatile("s_waitcnt vmcnt(0)" ::: "memory");
        }
    }
    __syncthreads();
}

struct Frame {
    LAS unsigned char* lds;
    int tid, lane, wave, vcu, G, gw, NGW;
    const float* in[18];
    float* out; unsigned char* ws;
};
__device__ __forceinline__ const float* src_row(const Frame& F, int r) {
    return r < MX ? F.in[I_X] + (size_t)r * D : F.in[I_CTX] + (size_t)(r - MX) * D;
}
__device__ __forceinline__ float* stream_row(const Frame& F, int r) {
    return r < MX ? F.out + (size_t)r * D : (float*)(F.ws + WS_XC) + (size_t)(r - MX) * D;
}
__device__ __forceinline__ const float* modp(const Frame& F, int layer, int mrow, int idx) {
    return (const float*)(F.ws + WS_MOD) + ((size_t)(layer * 9 + mrow) * NMOD + idx * D);
}
__device__ __forceinline__ void ld_row(const float* p, int lane, f32x4 (&v)[4]) {
#pragma unroll
    for (int j = 0; j < 4; ++j) v[j] = ((const f32x4*)p)[64 * j + lane];
}
__device__ __forceinline__ void st_row(float* p, int lane, const f32x4 (&v)[4]) {
#pragma unroll
    for (int j = 0; j < 4; ++j) ((f32x4*)p)[64 * j + lane] = v[j];
}
__device__ __forceinline__ void ld_row_bf(const bf16_t* p, int lane, f32x4 (&v)[4]) {
#pragma unroll
    for (int j = 0; j < 4; ++j) { const u32x2 w = ((const u32x2*)p)[64 * j + lane]; v[j] = (f32x4){bflo(w.x), bfhi(w.x), bflo(w.y), bfhi(w.y)}; }
}
__device__ __forceinline__ void st_row_bf(bf16_t* p, int lane, const f32x4 (&v)[4]) {
#pragma unroll
    for (int j = 0; j < 4; ++j) { u32x2 w; w.x = pk2(v[j][0], v[j][1]); w.y = pk2(v[j][2], v[j][3]); ((u32x2*)p)[64 * j + lane] = w; }
}
__device__ __forceinline__ float sumsq(const f32x4 (&v)[4]) {
    float s = 0.f;
#pragma unroll
    for (int j = 0; j < 4; ++j) s += (v[j][0] * v[j][0] + v[j][1] * v[j][1]) + (v[j][2] * v[j][2] + v[j][3] * v[j][3]);
    return s;
}
__device__ __forceinline__ void modulate_row_bf(const f32x4 (&x)[4], float rstd, const float* g, const float* sc, const float* sh, int lane, bf16_t* o) {
    f32x4 gv[4], scv[4], shv[4], h[4];
    ld_row(g, lane, gv); ld_row(sc, lane, scv); ld_row(sh, lane, shv);
#pragma unroll
    for (int j = 0; j < 4; ++j) h[j] = x[j] * rstd * gv[j] * (scv[j] + 1.f) + shv[j];
    st_row_bf(o, lane, h);
}

__device__ __forceinline__ void transpose_item(const float* W, int K, int N, bf16_t* WT, int row_off, LAS float* scr, int item, int lane) {
    const int nblk = N / 32, kb = item / nblk, nb = item % nblk, k0 = 64 * kb, n0 = 32 * nb;
#pragma unroll 8
    for (int i = 0; i < 32; ++i) { const int kk = 2 * i + (lane >> 5); scr[kk * 33 + (lane & 31)] = W[(size_t)(k0 + kk) * N + n0 + (lane & 31)]; }
    LDS_WAIT(); asm volatile("" ::: "memory");
    const int c = lane & 7;
#pragma unroll
    for (int j = 0; j < 4; ++j) { const int n = (lane >> 3) + 8 * j; const LAS float* s = scr + (8 * c) * 33 + n;
        u32x4 o; o.x = pk2(s[0 * 33], s[1 * 33]); o.y = pk2(s[2 * 33], s[3 * 33]); o.z = pk2(s[4 * 33], s[5 * 33]); o.w = pk2(s[6 * 33], s[7 * 33]);
        *(u32x4*)(WT + (size_t)(row_off + n0 + n) * K + k0 + 8 * c) = o; }
    LDS_WAIT(); asm volatile("" ::: "memory");
}

__device__ __forceinline__ void ph_p0(Frame& F) {
    LAS float* S = (LAS float*)(F.lds);
    LAS float* red = (LAS float*)(F.lds + 9 * 1024 * 4);
    if (F.vcu < 192) {
        for (int i = F.tid; i < 9 * 1024; i += NTHREADS) { const int r = i >> 10, k = i & 1023; const float c = r < 8 ? F.in[I_C][r * D + k] : F.in[I_CCTX][k]; S[i] = silu_f(c); }
        __syncthreads();
        for (int it = F.vcu; it < 192; it += F.G) {
            const int l = it / 96, j0 = (it % 96) * 64;
            const float* W = F.in[I_MODW] + (size_t)l * D * NMOD + j0 + F.lane;
            float acc[9];
#pragma unroll
            for (int r = 0; r < 9; ++r) acc[r] = 0.f;
            const int kb = F.wave * 128;
#pragma unroll 8
            for (int k = 0; k < 128; ++k) { const float w = W[(size_t)(kb + k) * NMOD];
#pragma unroll
                for (int r = 0; r < 9; ++r) acc[r] += S[r * 1024 + kb + k] * w; }
#pragma unroll
            for (int r = 0; r < 9; ++r) red[(F.wave * 9 + r) * 64 + F.lane] = acc[r];
            __syncthreads();
            for (int i = F.tid; i < 9 * 64; i += NTHREADS) { const int r = i >> 6, ln = i & 63; float s = F.in[I_MODB][l * NMOD + j0 + ln];
#pragma unroll
                for (int w = 0; w < 8; ++w) s += red[(w * 9 + r) * 64 + ln];
                ((float*)(F.ws + WS_MOD))[(size_t)(l * 9 + r) * NMOD + j0 + ln] = s; }
            __syncthreads();
        }
    }
    __syncthreads();
    LAS float* scr = (LAS float*)(F.lds + 55296 + F.wave * 8448);
    constexpr int I_P = (256 / 64) * (256 / 32);
    constexpr int I_F1 = (D / 64) * (NFF / 32);
    constexpr int NIT = 4 * I_P + I_F1;
    for (int it = F.gw; it < NIT; it += F.NGW) {
        int r = it;
        if (r < 4 * I_P) { const int g = r / I_P; transpose_item(F.in[I_POOLW] + (size_t)g * 256 * 256, 256, 256, (bf16_t*)(F.ws + WS_WP), g * 256, scr, r % I_P, F.lane); continue; } r -= 4 * I_P;
        transpose_item(F.in[I_FWIN], D, NFF, (bf16_t*)(F.ws + WS_WF1), 0, scr, r, F.lane);
    }
}

__device__ __forceinline__ void ph_pool(Frame& F) {
    LAS float* hbuf = (LAS float*)(F.lds);
    LAS float* rs = (LAS float*)(F.lds + 80 * 256 * 4);
    bf16_t* YP = (bf16_t*)(F.ws + WS_H);
    const float* g0 = F.in[I_NORMG];
    for (int ti = F.vcu; ti < 288; ti += F.G) {
        int R0, W, p0, mrow;
        if (ti < 256) { R0 = ti * 64; W = 64; p0 = 0; mrow = ti >> 5; }
        else { const int cb = (ti - 256) >> 2, seg = (ti - 256) & 3; R0 = MX + cb * 256; W = 256; p0 = seg * 64; mrow = 8; }
        const int ps = p0 - 8 > 0 ? p0 - 8 : 0, pe = p0 + 72 < W ? p0 + 72 : W, nl = pe - ps;
        for (int i = F.wave; i < nl; i += NWAVES) { f32x4 v[4]; ld_row(src_row(F, R0 + ps + i), F.lane, v); const float ss = wave_sum(sumsq(v)); if (F.lane == 0) rs[i] = rsqrtf(ss * (1.f / D) + EPS); }
        __syncthreads();
        const float* sc = modp(F, 0, mrow, 1); const float* sh = modp(F, 0, mrow, 0);
        for (int gi = 0; gi < 4; ++gi) {
            { const int c4 = (F.tid & 63) * 4, cg = gi * 256 + c4;
              const f32x4 gv = *(const f32x4*)(g0 + cg), scv = *(const f32x4*)(sc + cg), shv = *(const f32x4*)(sh + cg);
              for (int i = F.tid >> 6; i < nl; i += 8) { const f32x4 xv = *(const f32x4*)(src_row(F, R0 + ps + i) + cg); const float r = rs[i];
                  *(LAS f32x4*)(hbuf + i * 256 + c4) = xv * r * gv * (scv + 1.f) + shv; } }
            __syncthreads();
            { const int c2 = (F.tid & 127) * 2, q = F.tid >> 7; const int win = 2 << gi;
              for (int pp = 0; pp < 16; ++pp) { const int p = p0 + q * 16 + pp;
                  int lo = p - win / 2; lo = lo < 0 ? 0 : lo; int hi = p - win / 2 + win; hi = hi > W ? W : hi;
                  float s0 = 0.f, s1 = 0.f;
                  for (int s = lo; s < hi; ++s) { const f32x2 hv = *(const LAS f32x2*)(hbuf + (s - ps) * 256 + c2); s0 += hv.x; s1 += hv.y; }
                  const float inv = 1.f / (float)(hi - lo); const f32x2 hc = *(const LAS f32x2*)(hbuf + (p - ps) * 256 + c2);
                  *(unsigned*)(YP + (size_t)(R0 + p) * D + gi * 256 + c2) = pk2(s0 * inv - hc.x, s1 * inv - hc.y); } }
            __syncthreads();
        }
    }
}

__device__ __forceinline__ void resid_row(const Frame& F, int r, const f32x4 (&y)[4], const float* xin, const float* gy, const float* gate,
                                          float* xout, const float* g2, const float* sc2, const float* sh2, bf16_t* hout) {
    const float rstd = rsqrtf(wave_sum(sumsq(y)) * (1.f / D) + EPS);
    f32x4 xv[4], gv[4], gt[4];
    ld_row(xin, F.lane, xv); ld_row(gy, F.lane, gv); ld_row(gate, F.lane, gt);
#pragma unroll
    for (int j = 0; j < 4; ++j) xv[j] = xv[j] + gt[j] * (y[j] * rstd * gv[j]);
    st_row(xout, F.lane, xv);
    if (hout) { const float rstd2 = rsqrtf(wave_sum(sumsq(xv)) * (1.f / D) + EPS); modulate_row_bf(xv, rstd2, g2, sc2, sh2, F.lane, hout); }
}

__device__ __forceinline__ void ph_e2(Frame& F) {
    const float* Y = (const float*)(F.ws + WS_Y0); bf16_t* H = (bf16_t*)(F.ws + WS_H);
    const float* ng = F.in[I_NORMG];
    for (int r = F.gw; r < MT; r += F.NGW) {
        const int mr = mrow_of(r);
        f32x4 y[4], ps[4]; ld_row(Y + (size_t)r * D, F.lane, y); ld_row(F.in[I_POOLS], F.lane, ps);
#pragma unroll
        for (int j = 0; j < 4; ++j) y[j] = y[j] * ps[j];
        resid_row(F, r, y, src_row(F, r), ng + 1 * D, modp(F, 0, mr, 2), stream_row(F, r), ng + 2 * D, modp(F, 0, mr, 4), modp(F, 0, mr, 3), H + (size_t)r * D);
    }
}
__device__ __forceinline__ void ph_e4(Frame& F) {
    bf16_t* H = (bf16_t*)(F.ws + WS_H);
    const float* ng = F.in[I_NORMG];
    for (int r = F.gw; r < MT; r += F.NGW) {
        const int mr = mrow_of(r);
        f32x4 y[4]; ld_row_bf(H + (size_t)r * D, F.lane, y);
        resid_row(F, r, y, stream_row(F, r), ng + 3 * D, modp(F, 0, mr, 5), stream_row(F, r), ng + 4 * D, modp(F, 1, mr, 1), modp(F, 1, mr, 0), H + (size_t)r * D);
    }
    LAS float* scr = (LAS float*)(F.lds + F.wave * 8448);
    constexpr int I_WI = (D / 64) * (INW / 32), I_WO = (D / 64) * (D / 32), I_F1 = (D / 64) * (NFF / 32), I_F2 = (DFF / 64) * (D / 32), I_ZP = (INWP - INW);
    constexpr int NIT = I_WI + I_WO + I_F1 + I_F2 + I_ZP;
    for (int it = F.gw; it < NIT; it += F.NGW) {
        int r = it;
        if (r < I_WI) { transpose_item(F.in[I_MWIN], D, INW, (bf16_t*)(F.ws + WS_WI), 0, scr, r, F.lane); continue; } r -= I_WI;
        if (r < I_WO) { transpose_item(F.in[I_MWOUT], D, D, (bf16_t*)(F.ws + WS_WO), 0, scr, r, F.lane); continue; } r -= I_WO;
        if (r < I_F1) { transpose_item(F.in[I_FWIN] + (size_t)D * NFF, D, NFF, (bf16_t*)(F.ws + WS_WF1), 0, scr, r, F.lane); continue; } r -= I_F1;
        if (r < I_F2) { transpose_item(F.in[I_FWOUT] + (size_t)DFF * D, DFF, D, (bf16_t*)(F.ws + WS_WF2B), 0, scr, r, F.lane); continue; } r -= I_F2;
        { u32x4* row = (u32x4*)((bf16_t*)(F.ws + WS_WI) + (size_t)(INW + r) * D); row[F.lane] = (u32x4){0u, 0u, 0u, 0u}; row[64 + F.lane] = (u32x4){0u, 0u, 0u, 0u}; }
    }
}
__device__ __forceinline__ void ph_e7(Frame& F) {
    const float* Y = (const float*)(F.ws + WS_Y1); bf16_t* H = (bf16_t*)(F.ws + WS_H);
    const float* ng = F.in[I_NORMG] + 4 * D;
    for (int r = F.gw; r < MX; r += F.NGW) {
        const int mr = r >> 11;
        f32x4 y[4]; ld_row(Y + (size_t)r * D, F.lane, y);
        resid_row(F, r, y, F.out + (size_t)r * D, ng + 1 * D, modp(F, 1, mr, 2), F.out + (size_t)r * D, ng + 2 * D, modp(F, 1, mr, 4), modp(F, 1, mr, 3), H + (size_t)r * D);
    }
}
__device__ __forceinline__ void ph_e9(Frame& F) {
    const bf16_t* FX = (const bf16_t*)(F.ws + WS_H);
    const float* ng = F.in[I_NORMG] + 4 * D;
    for (int r = F.gw; r < MX; r += F.NGW) {
        const int mr = r >> 11;
        f32x4 y[4]; ld_row_bf(FX + (size_t)r * D, F.lane, y);
        resid_row(F, r, y, F.out + (size_t)r * D, ng + 3 * D, modp(F, 1, mr, 5), F.out + (size_t)r * D, nullptr, nullptr, nullptr, nullptr);
    }
}

__device__ __forceinline__ void conv8(const bf16_t* src, int sld, int r, int c, const float* w, int wld, float (&acc)[8]) {
    int a_lo, a_hi, jj, Wd;
    if (r < MX) { const int n = r & (SEQ - 1), i = n >> 6; jj = n & 63; Wd = 64; a_lo = i > 0 ? 0 : 1; a_hi = i < 31 ? 2 : 1; }
    else { jj = (r - MX) & 255; Wd = 256; a_lo = 1; a_hi = 1; }
    const int b_lo = jj > 0 ? 0 : 1, b_hi = jj < Wd - 1 ? 2 : 1;
    for (int a = a_lo; a <= a_hi; ++a)
        for (int b = b_lo; b <= b_hi; ++b) {
            const int rn = r + (a - 1) * 64 + (b - 1);
            const u32x4 gv = *(const u32x4*)(src + (size_t)rn * sld + c);
            const float* wp = w + (a * 3 + b) * wld + c; const f32x4 w0 = *(const f32x4*)wp, w1 = *(const f32x4*)(wp + 4);
            acc[0] += bflo(gv.x) * w0[0]; acc[1] += bfhi(gv.x) * w0[1]; acc[2] += bflo(gv.y) * w0[2]; acc[3] += bfhi(gv.y) * w0[3];
            acc[4] += bflo(gv.z) * w1[0]; acc[5] += bfhi(gv.z) * w1[1]; acc[6] += bflo(gv.w) * w1[2]; acc[7] += bfhi(gv.w) * w1[3];
        }
}
__device__ __forceinline__ void ph_ffn_conv(Frame& F, bf16_t* UG, int M, int layer) {
    const float* cw = F.in[I_FCW] + (size_t)layer * 9 * DFF; const float* cb = F.in[I_FCB] + (size_t)layer * DFF;
    const int ntask = M * (DFF / 8);
    for (int t = F.vcu * NTHREADS + F.tid; t < ntask; t += F.G * NTHREADS) {
        const int r = t / (DFF / 8), c = (t % (DFF / 8)) * 8;
        float acc[8];
        { const f32x4 b0 = *(const f32x4*)(cb + c), b1 = *(const f32x4*)(cb + c + 4); acc[0] = b0[0]; acc[1] = b0[1]; acc[2] = b0[2]; acc[3] = b0[3]; acc[4] = b1[0]; acc[5] = b1[1]; acc[6] = b1[2]; acc[7] = b1[3]; }
        conv8(UG + DFF, NFF, r, c, cw, DFF, acc);
        u32x4* up = (u32x4*)(UG + (size_t)r * NFF + c); const u32x4 uv = *up;
        u32x4 o;
        o.x = pk2(silu_f(acc[0]) * bflo(uv.x), silu_f(acc[1]) * bfhi(uv.x)); o.y = pk2(silu_f(acc[2]) * bflo(uv.y), silu_f(acc[3]) * bfhi(uv.y));
        o.z = pk2(silu_f(acc[4]) * bflo(uv.z), silu_f(acc[5]) * bfhi(uv.z)); o.w = pk2(silu_f(acc[6]) * bflo(uv.w), silu_f(acc[7]) * bfhi(uv.w));
        *up = o;
    }
}
__device__ __forceinline__ void ph_e3(Frame& F) {
    ph_ffn_conv(F, (bf16_t*)(F.ws + WS_UG0), MT, 0);
    LAS float* scr = (LAS float*)(F.lds + F.wave * 8448);
    constexpr int I_F2 = (DFF / 64) * (D / 32);
    for (int it = F.gw; it < I_F2; it += F.NGW) transpose_item(F.in[I_FWOUT], DFF, D, (bf16_t*)(F.ws + WS_WF2A), 0, scr, it, F.lane);
}
__device__ __forceinline__ void ph_e5(Frame& F) {
    const bf16_t* Z = (const bf16_t*)(F.ws + WS_Z); bf16_t* QK = (bf16_t*)(F.ws + WS_H); float* GT = (float*)(F.ws + WS_GT);
    const float* cw = F.in[I_MCW]; const float* cb = F.in[I_MCB];
    const int ntask = MT * 128;
    for (int t = F.vcu * NTHREADS + F.tid; t < ntask; t += F.G * NTHREADS) {
        const int r = t >> 7, c = (t & 127) * 8;
        float acc[8];
        { const f32x4 b0 = *(const f32x4*)(cb + c), b1 = *(const f32x4*)(cb + c + 4); acc[0] = b0[0]; acc[1] = b0[1]; acc[2] = b0[2]; acc[3] = b0[3]; acc[4] = b1[0]; acc[5] = b1[1]; acc[6] = b1[2]; acc[7] = b1[3]; }
        conv8(Z, ZW, r, c, cw, D, acc);
        const float s = c >= 512 ? 0.125f : 1.f;
        u32x4 o;
        o.x = pk2(silu_f(acc[0]) * s, silu_f(acc[1]) * s); o.y = pk2(silu_f(acc[2]) * s, silu_f(acc[3]) * s);
        o.z = pk2(silu_f(acc[4]) * s, silu_f(acc[5]) * s); o.w = pk2(silu_f(acc[6]) * s, silu_f(acc[7]) * s);
        *(u32x4*)(QK + (size_t)r * D + c) = o;
    }
    for (int t = F.vcu * NTHREADS + F.tid; t < MT * 32; t += F.G * NTHREADS) {
        const int j = t & 31; float v = GT[t] + F.in[I_MBG][j];
        if (j >= 16) v = logsigmoid_f(v);
        GT[t] = v;
    }
}
__device__ __forceinline__ void ph_e6(Frame& F) {
    const bf16_t* Z = (const bf16_t*)(F.ws + WS_Z); bf16_t* HF = (bf16_t*)(F.ws + WS_HF); const bf16_t* HB = (const bf16_t*)(F.ws + WS_HB);
    for (int t = F.vcu * NTHREADS + F.tid; t < MX * 128; t += F.G * NTHREADS) {
        const int r = t >> 7, c = (t & 127) * 8;
        const u32x4 ov = *(const u32x4*)(Z + (size_t)r * ZW + 2048 + c), a = *(const u32x4*)(HF + (size_t)r * D + c), b = *(const u32x4*)(HB + (size_t)r * D + c);
        u32x4 o;
        o.x = pk2(sigmoid_f(bflo(ov.x)) * (bflo(a.x) + bflo(b.x)), sigmoid_f(bfhi(ov.x)) * (bfhi(a.x) + bfhi(b.x)));
        o.y = pk2(sigmoid_f(bflo(ov.y)) * (bflo(a.y) + bflo(b.y)), sigmoid_f(bfhi(ov.y)) * (bfhi(a.y) + bfhi(b.y)));
        o.z = pk2(sigmoid_f(bflo(ov.z)) * (bflo(a.z) + bflo(b.z)), sigmoid_f(bfhi(ov.z)) * (bfhi(a.z) + bfhi(b.z)));
        o.w = pk2(sigmoid_f(bflo(ov.w)) * (bflo(a.w) + bflo(b.w)), sigmoid_f(bfhi(ov.w)) * (bfhi(a.w) + bfhi(b.w)));
        *(u32x4*)(HF + (size_t)r * D + c) = o;
    }
}


__device__ __forceinline__ void ph_mlstm_rec(Frame& F) {
    const bf16_t* QK = (const bf16_t*)(F.ws + WS_H); const bf16_t* Z = (const bf16_t*)(F.ws + WS_Z); const float* GT = (const float*)(F.ws + WS_GT);
    bf16_t* HF = (bf16_t*)(F.ws + WS_HF); bf16_t* HB = (bf16_t*)(F.ws + WS_HB);
    LAS float* sq = (LAS float*)(F.lds); LAS float* sk = sq + 64; LAS float* part = sq + 128;
    for (int it = F.vcu; it < 128; it += F.G) {
        const int dir = it & 1, h = (it >> 1) & 7, b = it >> 4, v = F.tid & 127, sub = F.tid >> 7;
        float C[16], n[16];
#pragma unroll
        for (int j = 0; j < 16; ++j) { C[j] = 0.f; n[j] = 0.f; }
        float m = 0.f;
        for (int s = 0; s < CTXL + SEQ; ++s) {
            int r;
            if (s < CTXL) { const int j = dir ? CTXL - 1 - s : s; r = MX + b * CTXL + j; } else { int j = s - CTXL; if (dir) j = SEQ - 1 - j; r = b * SEQ + j; }
            if (F.tid < 64) sq[F.tid] = bf2f(QK[(size_t)r * D + h * 64 + F.tid]); else if (F.tid < 128) sk[F.tid - 64] = bf2f(QK[(size_t)r * D + 512 + h * 64 + (F.tid - 64)]);
            const float vv = bf2f(Z[(size_t)r * ZW + 1024 + h * 128 + v]);
            const float ig = GT[(size_t)r * 32 + dir * 8 + h], lf = GT[(size_t)r * 32 + 16 + dir * 8 + h];
            __syncthreads();
            const float mn = fmaxf(lf + m, ig), fa = __expf(lf + m - mn), fi = __expf(ig - mn);
            float num = 0.f, den = 0.f;
#pragma unroll
            for (int j = 0; j < 16; ++j) { const float kj = sk[sub * 16 + j], qj = sq[sub * 16 + j]; C[j] = fa * C[j] + fi * kj * vv; n[j] = fa * n[j] + fi * kj; num += qj * C[j]; den += qj * n[j]; }
            m = mn;
            part[sub * 128 + v] = num; part[(4 + sub) * 128 + v] = den;
            __syncthreads();
            if (sub == 0 && s >= CTXL) {
                const float nu = (part[v] + part[128 + v]) + (part[256 + v] + part[384 + v]), de = (part[512 + v] + part[640 + v]) + (part[768 + v] + part[896 + v]);
                const float hh = nu / fmaxf(fabsf(de), __expf(-mn)); (dir ? HB : HF)[(size_t)r * D + h * 128 + v] = (bf16_t)f2bf(hh);
            }
        }
        __syncthreads();
    }
}


__device__ __forceinline__ bf16x8 pack8(const f32x4 a, const f32x4 b) {
    u32x4 w; w.x = pg8::cvt_pk_bf16(a[0], a[1]); w.y = pg8::cvt_pk_bf16(a[2], a[3]); w.z = pg8::cvt_pk_bf16(b[0], b[1]); w.w = pg8::cvt_pk_bf16(b[2], b[3]);
    return __builtin_bit_cast(bf16x8, w);
}
__device__ __forceinline__ bf16x8 ld_split(const LAS unsigned char* p) {
    const u32x2 a = *(const LAS u32x2*)p, b = *(const LAS u32x2*)(p + 32);
    u32x4 w; w.x = a.x; w.y = a.y; w.z = b.x; w.w = b.y; return __builtin_bit_cast(bf16x8, w);
}
__device__ __forceinline__ int tok_row(int b, int dir, int c, int s) {
    int p = 64 * c + s;
    if (c < 4) { const int j = dir ? CTXL - 1 - p : p; return MX + b * CTXL + j; }
    p -= CTXL; const int j = dir ? SEQ - 1 - p : p; return b * SEQ + j;
}
#define MFMA16(a, b, c) __builtin_amdgcn_mfma_f32_16x16x32_bf16((a), (b), (c), 0, 0, 0)
__device__ __forceinline__ void ph_mlstm(Frame& F) {
    const bf16_t* QK = (const bf16_t*)(F.ws + WS_H); const bf16_t* Z = (const bf16_t*)(F.ws + WS_Z); const float* GT = (const float*)(F.ws + WS_GT);
    constexpr int RS = 144, TB = 64 * RS, BUFB = 4 * TB, NCH = (CTXL + SEQ) / 64;
    const int lane = F.lane, w = F.wave, l15 = lane & 15, q = lane >> 4, vt = w & 3, th = w >> 2;
    const int tt0 = th ? 1 : 0, tt1 = th ? 2 : 3;
    const f32x4 zero4 = (f32x4){0.f, 0.f, 0.f, 0.f};
    bf16x8 ones; { u32x4 o1 = (u32x4){0x3F803F80u, 0x3F803F80u, 0x3F803F80u, 0x3F803F80u}; ones = __builtin_bit_cast(bf16x8, o1); }
    for (int item = F.vcu; item < 256; item += F.G) {
        const int seq = item >> 1, vh = item & 1, dir = seq & 1, h = (seq >> 1) & 7, b = seq >> 4;
        bf16_t* Hout = (bf16_t*)(F.ws + (dir ? WS_HB : WS_HF));
        f32x4 Cacc[4], nacc[4];
#pragma unroll
        for (int i = 0; i < 4; ++i) { Cacc[i] = zero4; nacc[i] = zero4; }
        float m_in = 0.f, bb, u, mm, adec;
        u32x4 qv, kv, vv; float lfn, ign;
#define ML_LOAD(cc) do { const int r_ = tok_row(b, dir, (cc), lane); \
            qv = *(const u32x4*)(QK + (size_t)r_ * D + h * 64 + 8 * w); kv = *(const u32x4*)(QK + (size_t)r_ * D + 512 + h * 64 + 8 * w); \
            vv = *(const u32x4*)(Z + (size_t)r_ * ZW + 1024 + h * 128 + vh * 64 + 8 * w); \
            ign = GT[(size_t)r_ * 32 + dir * 8 + h]; lfn = GT[(size_t)r_ * 32 + 16 + dir * 8 + h]; } while (0)
#define ML_SCAN_WRITE(cc) do { \
            bb = lfn; _Pragma("unroll") for (int o_ = 1; o_ < 64; o_ <<= 1) { const float t_ = __shfl_up(bb, o_); if (lane >= o_) bb += t_; } \
            u = ign - bb; float M_ = u; _Pragma("unroll") for (int o_ = 1; o_ < 64; o_ <<= 1) { const float t_ = __shfl_up(M_, o_); if (lane >= o_) M_ = fmaxf(M_, t_); } \
            mm = fmaxf(m_in, M_); const float mm63_ = __shfl(mm, 63); adec = __expf(m_in - mm63_); const float wg_ = __expf(u - mm63_); \
            LAS unsigned char* B_ = F.lds + ((cc) & 1) * BUFB; \
            *(LAS u32x4*)(B_ + lane * RS + 16 * w) = qv; *(LAS u32x4*)(B_ + TB + lane * RS + 16 * w) = kv; \
            { const unsigned kw_[4] = {kv.x, kv.y, kv.z, kv.w}, vw_[4] = {vv.x, vv.y, vv.z, vv.w}; \
              _Pragma("unroll") for (int i_ = 0; i_ < 4; ++i_) { \
                *(LAS unsigned short*)(B_ + 2 * TB + (8 * w + 2 * i_) * RS + 2 * lane) = (unsigned short)f2bf(bflo(kw_[i_]) * wg_); \
                *(LAS unsigned short*)(B_ + 2 * TB + (8 * w + 2 * i_ + 1) * RS + 2 * lane) = (unsigned short)f2bf(bfhi(kw_[i_]) * wg_); \
                *(LAS unsigned short*)(B_ + 3 * TB + (8 * w + 2 * i_) * RS + 2 * lane) = (unsigned short)(vw_[i_] & 0xffffu); \
                *(LAS unsigned short*)(B_ + 3 * TB + (8 * w + 2 * i_ + 1) * RS + 2 * lane) = (unsigned short)(vw_[i_] >> 16); } } } while (0)
        ML_LOAD(0); ML_SCAN_WRITE(0);
        __syncthreads();
        for (int c = 0; c < NCH; ++c) {
            const float m_cur = m_in, bb_c = bb, u_c = u, mm_c = mm, adec_c = adec;
            if (c + 1 < NCH) ML_LOAD(c + 1);
            const LAS unsigned char* QS = F.lds + (c & 1) * BUFB; const LAS unsigned char* KS = QS + TB; const LAS unsigned char* KT = QS + 2 * TB; const LAS unsigned char* VT = QS + 3 * TB;
            if (c >= 4) {
                float us[4][4];
#pragma unroll
                for (int ss = 0; ss < 4; ++ss)
#pragma unroll
                    for (int i = 0; i < 4; ++i) us[ss][i] = __shfl(u_c, 16 * ss + 4 * q + i);
                const bf16x8 ca0 = pack8(Cacc[0], Cacc[1]), ca1 = pack8(Cacc[2], Cacc[3]), na0 = pack8(nacc[0], nacc[1]), na1 = pack8(nacc[2], nacc[3]);
                const bf16x8 va0 = ld_split(VT + (16 * vt + l15) * RS + 8 * q), va1 = ld_split(VT + (16 * vt + l15) * RS + 64 + 8 * q);
#pragma unroll
                for (int ti = 0; ti < 2; ++ti) {
                    const int tt = ti ? tt1 : tt0, tl = 16 * tt + l15;
                    const float mmt = __shfl(mm_c, tl), bt = __shfl(bb_c, tl);
                    const bf16x8 qn0 = *(const LAS bf16x8*)(QS + tl * RS + 16 * q), qn1 = *(const LAS bf16x8*)(QS + tl * RS + 64 + 16 * q);
                    f32x4 PT[4];
#pragma unroll
                    for (int ss = 0; ss < 4; ++ss) {
                        if (ss <= tt) {
                            const bf16x8 k0 = *(const LAS bf16x8*)(KS + (16 * ss + l15) * RS + 16 * q), k1 = *(const LAS bf16x8*)(KS + (16 * ss + l15) * RS + 64 + 16 * q);
                            f32x4 a = MFMA16(k0, qn0, zero4); a = MFMA16(k1, qn1, a);
#pragma unroll
                            for (int i = 0; i < 4; ++i) { const int sp = 16 * ss + 4 * q + i; const float wgt = __expf(us[ss][i] - mmt); a[i] = (sp <= tl) ? a[i] * wgt : 0.f; }
                            PT[ss] = a;
                        } else PT[ss] = zero4;
                    }
                    const bf16x8 pb0 = pack8(PT[0], PT[1]), pb1 = pack8(PT[2], PT[3]);
                    f32x4 aPV = MFMA16(va0, pb0, zero4); aPV = MFMA16(va1, pb1, aPV);
                    f32x4 rsum = MFMA16(ones, pb0, zero4); rsum = MFMA16(ones, pb1, rsum);
                    const bf16x8 qs0 = ld_split(QS + tl * RS + 8 * q), qs1 = ld_split(QS + tl * RS + 64 + 8 * q);
                    f32x4 aQC = MFMA16(ca0, qs0, zero4); aQC = MFMA16(ca1, qs1, aQC);
                    f32x4 qn = MFMA16(na0, qs0, zero4); qn = MFMA16(na1, qs1, qn);
                    const float at = __expf(m_cur - mmt), fl = __expf(-(bt + mmt));
                    float hh[4];
#pragma unroll
                    for (int i = 0; i < 4; ++i) { const float den = rsum[i] + at * qn[i]; hh[i] = (aPV[i] + at * aQC[i]) / fmaxf(fabsf(den), fl); }
                    const int row = tok_row(b, dir, c, tl);
                    u32x2 o; o.x = pk2(hh[0], hh[1]); o.y = pk2(hh[2], hh[3]);
                    *(u32x2*)(Hout + (size_t)row * D + h * 128 + vh * 64 + vt * 16 + 4 * q) = o;
                }
            }
            {
                const bf16x8 vb0 = *(const LAS bf16x8*)(VT + (16 * vt + l15) * RS + 16 * q), vb1 = *(const LAS bf16x8*)(VT + (16 * vt + l15) * RS + 64 + 16 * q);
#pragma unroll
                for (int dt = 0; dt < 4; ++dt) {
                    const bf16x8 kt0 = *(const LAS bf16x8*)(KT + (16 * dt + l15) * RS + 16 * q), kt1 = *(const LAS bf16x8*)(KT + (16 * dt + l15) * RS + 64 + 16 * q);
                    f32x4 cc = Cacc[dt] * adec_c, nn = nacc[dt] * adec_c;
                    cc = MFMA16(kt0, vb0, cc); cc = MFMA16(kt1, vb1, cc); nn = MFMA16(kt0, ones, nn); nn = MFMA16(kt1, ones, nn);
                    Cacc[dt] = cc; nacc[dt] = nn;
                }
            }
            if (c + 1 < NCH) { m_in = __shfl(bb_c, 63) + __shfl(mm_c, 63); ML_SCAN_WRITE(c + 1); }
            __syncthreads();
        }
#undef ML_LOAD
#undef ML_SCAN_WRITE
    }
}

#ifndef USE_MFMA_GEMM
#define USE_MFMA_GEMM 1
#endif
#ifndef SINGLE_LAUNCH
#define SINGLE_LAUNCH 1
#endif
#ifndef NAIVE_MLSTM
#define NAIVE_MLSTM 0
#endif
#ifndef MLSTM_REC
#define MLSTM_REC 0
#endif
template <class Epi, bool ALIGN>
__device__ __forceinline__ void run_gemm(Frame& F, const bf16_t* A, const bf16_t* Bt, int M, int N, int K, int lda, int ldb, int akoff, const Epi& E) {
    pg8::Gemm g{A, Bt, M, N, K, lda, ldb, akoff}; pg8::StaticOrder S; S.init(M, N, F.G, (int)blockIdx.x);
    pg8::gemm_phase<Epi, pg8::StaticOrder, ALIGN>(F.lds + RING_OFF, g, S, E);
}

__global__ void __launch_bounds__(NTHREADS, 2) mega(P args) {
    extern __shared__ __attribute__((aligned(16))) unsigned char lds[];
    Frame F;
    F.lds = (LAS unsigned char*)lds;
    F.tid = threadIdx.x; F.lane = F.tid & 63; F.wave = __builtin_amdgcn_readfirstlane(F.tid >> 6);
    F.G = gridDim.x; { const int bx = blockIdx.x; F.vcu = (F.G % 8 == 0) ? (bx % 8) * (F.G / 8) + bx / 8 : bx; }
    F.gw = F.vcu * NWAVES + F.wave; F.NGW = F.G * NWAVES;
#pragma unroll
    for (int i = 0; i < 18; ++i) F.in[i] = args.in[i];
    F.out = args.out; F.ws = args.ws;
    volatile LAS unsigned* MISC = (volatile LAS unsigned*)(F.lds + MISC_OFF);
    for (int u = F.tid; u < (LDS_BYTES - LDSCTL_OFF) / 4; u += NTHREADS) ((LAS unsigned*)(F.lds + LDSCTL_OFF))[u] = 0u;
    __syncthreads();
    const int lo = args.lo, hi = args.hi;
    XcdBarrier bar; bar.bar = (unsigned*)(F.ws + WS_CTL) + CW_BAR; bar.x = 0; bar.st = nullptr;
    if (hi - lo > 1) bar = xcd_barrier_post((unsigned*)(F.ws + WS_CTL) + CW_BAR, MISC + 8);
#define IN(k) (lo <= (k) && (k) < hi)
#define SEAM(k) do { if (IN(k) && IN((k) + 1)) xcd_barrier(bar); } while (0)
    unsigned char* ws = F.ws;
    if (IN(PH_P0)) { ph_p0(F); } SEAM(PH_P0);
    if (IN(PH_POOL)) { ph_pool(F); } SEAM(PH_POOL);
    if (IN(PH_G1)) { pg8::EpiF32 E{(float*)(ws + WS_Y0), D}; run_gemm<pg8::EpiF32, true>(F, (const bf16_t*)(ws + WS_H), (const bf16_t*)(ws + WS_WP), MT, D, 256, D, 256, 256, E); } SEAM(PH_G1);
    if (IN(PH_E2)) { ph_e2(F); } SEAM(PH_E2);
    if (IN(PH_G2)) { pg8::EpiBf16 E{(bf16_t*)(ws + WS_UG0), NFF}; run_gemm<pg8::EpiBf16, true>(F, (const bf16_t*)(ws + WS_H), (const bf16_t*)(ws + WS_WF1), MT, NFF, D, D, D, 0, E); } SEAM(PH_G2);
    if (IN(PH_E3)) { ph_e3(F); } SEAM(PH_E3);
    if (IN(PH_G3)) { pg8::EpiBf16 E{(bf16_t*)(ws + WS_H), D}; run_gemm<pg8::EpiBf16, true>(F, (const bf16_t*)(ws + WS_UG0), (const bf16_t*)(ws + WS_WF2A), MT, D, DFF, NFF, DFF, 0, E); } SEAM(PH_G3);
    if (IN(PH_E4)) { ph_e4(F); } SEAM(PH_E4);
    if (IN(PH_G4)) { pg8::EpiZ E{(bf16_t*)(ws + WS_Z), (float*)(ws + WS_GT)}; run_gemm<pg8::EpiZ, true>(F, (const bf16_t*)(ws + WS_H), (const bf16_t*)(ws + WS_WI), MT, INWP, D, D, D, 0, E); } SEAM(PH_G4);
    if (IN(PH_E5)) { ph_e5(F); } SEAM(PH_E5);
    if (IN(PH_MLSTM)) {
#if MLSTM_REC
        ph_mlstm_rec(F);
#else
        ph_mlstm(F);
#endif
    } SEAM(PH_MLSTM);
    if (IN(PH_E6)) { ph_e6(F); } SEAM(PH_E6);
    if (IN(PH_G5)) { pg8::EpiF32 E{(float*)(ws + WS_Y1), D}; run_gemm<pg8::EpiF32, true>(F, (const bf16_t*)(ws + WS_HF), (const bf16_t*)(ws + WS_WO), MX, D, D, D, D, 0, E); } SEAM(PH_G5);
    if (IN(PH_E7)) { ph_e7(F); } SEAM(PH_E7);
    if (IN(PH_G6)) { pg8::EpiBf16 E{(bf16_t*)(ws + WS_UG1), NFF}; run_gemm<pg8::EpiBf16, true>(F, (const bf16_t*)(ws + WS_H), (const bf16_t*)(ws + WS_WF1), MX, NFF, D, D, D, 0, E); } SEAM(PH_G6);
    if (IN(PH_E8)) { ph_ffn_conv(F, (bf16_t*)(ws + WS_UG1), MX, 1); } SEAM(PH_E8);
    if (IN(PH_G7)) { pg8::EpiBf16 E{(bf16_t*)(ws + WS_H), D}; run_gemm<pg8::EpiBf16, true>(F, (const bf16_t*)(ws + WS_UG1), (const bf16_t*)(ws + WS_WF2B), MX, D, DFF, NFF, DFF, 0, E); } SEAM(PH_G7);
    if (IN(PH_E9)) { ph_e9(F); }
#undef IN
#undef SEAM
}

__global__ void __launch_bounds__(256) k_gemm_naive(const bf16_t* A, const bf16_t* Bt, int K, int lda, int ldb, int akoff, int mode, void* O, int ldc, float* GT) {
    __shared__ float As[16][65], Bs[16][65];
    const int n0 = blockIdx.x * 64, m0 = blockIdx.y * 64, tx = threadIdx.x & 15, ty = threadIdx.x >> 4;
    const bf16_t* Ab = A + (size_t)(n0 / 256) * akoff;
    float acc[4][4];
#pragma unroll
    for (int i = 0; i < 4; ++i)
#pragma unroll
        for (int j = 0; j < 4; ++j) acc[i][j] = 0.f;
    for (int k0 = 0; k0 < K; k0 += 16) {
        for (int i = threadIdx.x; i < 64 * 16; i += 256) { const int rr = i >> 4, kk = i & 15; As[kk][rr] = bf2f(Ab[(size_t)(m0 + rr) * lda + k0 + kk]); Bs[kk][rr] = bf2f(Bt[(size_t)(n0 + rr) * ldb + k0 + kk]); }
        __syncthreads();
#pragma unroll
        for (int kk = 0; kk < 16; ++kk) {
            float a[4], b[4];
#pragma unroll
            for (int i = 0; i < 4; ++i) { a[i] = As[kk][ty * 4 + i]; b[i] = Bs[kk][tx * 4 + i]; }
#pragma unroll
            for (int i = 0; i < 4; ++i)
#pragma unroll
                for (int j = 0; j < 4; ++j) acc[i][j] += a[i] * b[j];
        }
        __syncthreads();
    }
#pragma unroll
    for (int i = 0; i < 4; ++i)
#pragma unroll
        for (int j = 0; j < 4; ++j) {
            const int r = m0 + ty * 4 + i, c = n0 + tx * 4 + j;
            if (mode == 0) ((float*)O)[(size_t)r * ldc + c] = acc[i][j];
            else if (mode == 1) ((bf16_t*)O)[(size_t)r * ldc + c] = (bf16_t)f2bf(acc[i][j]);
            else { if (c < ZW) ((bf16_t*)O)[(size_t)r * ZW + c] = (bf16_t)f2bf(acc[i][j]); else if (c < ZW + 32) GT[(size_t)r * 32 + (c - ZW)] = acc[i][j]; }
        }
}
__global__ void __launch_bounds__(128) k_mlstm_naive(const bf16_t* QK, const bf16_t* Z, const float* GT, bf16_t* HF, bf16_t* HB) {
    const int bid = blockIdx.x, dir = bid & 1, h = (bid >> 1) & 7, b = bid >> 4, v = threadIdx.x;
    __shared__ float sq[64], sk[64];
    float C[64], n[64];
#pragma unroll
    for (int j = 0; j < 64; ++j) { C[j] = 0.f; n[j] = 0.f; }
    float m = 0.f;
    for (int s = 0; s < CTXL + SEQ; ++s) {
        int r;
        if (s < CTXL) { const int j = dir ? CTXL - 1 - s : s; r = MX + b * CTXL + j; } else { int j = s - CTXL; if (dir) j = SEQ - 1 - j; r = b * SEQ + j; }
        if (v < 64) sq[v] = bf2f(QK[(size_t)r * D + h * 64 + v]); else sk[v - 64] = bf2f(QK[(size_t)r * D + 512 + h * 64 + (v - 64)]);
        const float vv = bf2f(Z[(size_t)r * ZW + 1024 + h * 128 + v]);
        const float ig = GT[(size_t)r * 32 + dir * 8 + h], lf = GT[(size_t)r * 32 + 16 + dir * 8 + h];
        __syncthreads();
        const float mn = fmaxf(lf + m, ig), fa = __expf(lf + m - mn), fi = __expf(ig - mn);
        float num = 0.f, den = 0.f;
#pragma unroll
        for (int j = 0; j < 64; ++j) { const float kj = sk[j]; C[j] = fa * C[j] + fi * kj * vv; n[j] = fa * n[j] + fi * kj; num += sq[j] * C[j]; den += sq[j] * n[j]; }
        m = mn;
        if (s >= CTXL) { const float hh = num / fmaxf(fabsf(den), __expf(-mn)); (dir ? HB : HF)[(size_t)r * D + h * 128 + v] = (bf16_t)f2bf(hh); }
        __syncthreads();
    }
}

static void launch_naive_gemm(hipStream_t s, const bf16_t* A, const bf16_t* Bt, int M, int N, int K, int lda, int ldb, int akoff, int mode, void* O, int ldc, float* GT) {
    hipLaunchKernelGGL(k_gemm_naive, dim3(N / 64, M / 64), dim3(256), 0, s, A, Bt, K, lda, ldb, akoff, mode, O, ldc, GT);
}
extern "C" void kernel_launch(void* const* d_in, const int* in_sizes, int n_in, void* d_out, int out_size, void* d_ws, size_t ws_size, hipStream_t stream) {
    static int grid = 0;
    if (grid == 0) {
        if (n_in != 18 || out_size != MX * D || ws_size < WS_END) { fprintf(stderr, "kernel_launch: unexpected shapes n_in %d out %d ws %zu\n", n_in, out_size, ws_size); grid = -1; return; }
        int dev = 0, cus = 0, per_cu = 0;
        (void)hipGetDevice(&dev); (void)hipDeviceGetAttribute(&cus, hipDeviceAttributeMultiprocessorCount, dev);
        (void)hipFuncSetAttribute((const void*)mega, hipFuncAttributeMaxDynamicSharedMemorySize, LDS_BYTES);
        (void)hipOccupancyMaxActiveBlocksPerMultiprocessor(&per_cu, (const void*)mega, NTHREADS, LDS_BYTES);
        (void)hipGetLastError();
        if (per_cu < 1) fprintf(stderr, "kernel_launch: occupancy query says %d blocks/CU\n", per_cu);
        grid = cus;
    }
    if (grid < 0) return;
    (void)hipMemsetAsync((char*)d_ws + WS_CTL, 0, CTL_ZERO_BYTES, stream);
    P a{};
    for (int i = 0; i < 18; ++i) a.in[i] = (const float*)d_in[i];
    a.out = (float*)d_out; a.ws = (unsigned char*)d_ws;
    unsigned char* ws = (unsigned char*)d_ws;
#if SINGLE_LAUNCH
    a.lo = 0; a.hi = NPH;
    hipLaunchKernelGGL(mega, dim3(grid), dim3(NTHREADS), LDS_BYTES, stream, a);
    return;
#endif
    for (int ph = 0; ph < NPH; ++ph) {
        if (ph == PH_MLSTM && NAIVE_MLSTM) {
            hipLaunchKernelGGL(k_mlstm_naive, dim3(128), dim3(128), 0, stream, (const bf16_t*)(ws + WS_H), (const bf16_t*)(ws + WS_Z), (const float*)(ws + WS_GT), (bf16_t*)(ws + WS_HF), (bf16_t*)(ws + WS_HB));
            continue;
        }
#if !USE_MFMA_GEMM
        if (ph == PH_G1) { launch_naive_gemm(stream, (const bf16_t*)(ws + WS_H), (const bf16_t*)(ws + WS_WP), MT, D, 256, D, 256, 256, 0, ws + WS_Y0, D, nullptr); continue; }
        if (ph == PH_G2) { launch_naive_gemm(stream, (const bf16_t*)(ws + WS_H), (const bf16_t*)(ws + WS_WF1), MT, NFF, D, D, D, 0, 1, ws + WS_UG0, NFF, nullptr); continue; }
        if (ph == PH_G3) { launch_naive_gemm(stream, (const bf16_t*)(ws + WS_UG0), (const bf16_t*)(ws + WS_WF2A), MT, D, DFF, NFF, DFF, 0, 1, ws + WS_H, D, nullptr); continue; }
        if (ph == PH_G4) { launch_naive_gemm(stream, (const bf16_t*)(ws + WS_H), (const bf16_t*)(ws + WS_WI), MT, INWP, D, D, D, 0, 2, ws + WS_Z, ZW, (float*)(ws + WS_GT)); continue; }
        if (ph == PH_G5) { launch_naive_gemm(stream, (const bf16_t*)(ws + WS_HF), (const bf16_t*)(ws + WS_WO), MX, D, D, D, D, 0, 0, ws + WS_Y1, D, nullptr); continue; }
        if (ph == PH_G6) { launch_naive_gemm(stream, (const bf16_t*)(ws + WS_H), (const bf16_t*)(ws + WS_WF1), MX, NFF, D, D, D, 0, 1, ws + WS_UG1, NFF, nullptr); continue; }
        if (ph == PH_G7) { launch_naive_gemm(stream, (const bf16_t*)(ws + WS_UG1), (const bf16_t*)(ws + WS_WF2B), MX, D, DFF, NFF, DFF, 0, 1, ws + WS_H, D, nullptr); continue; }
#endif
        a.lo = ph; a.hi = ph + 1;
        hipLaunchKernelGGL(mega, dim3(grid), dim3(NTHREADS), LDS_BYTES, stream, a);
    }
}
```

```cpp
#include <hip/hip_runtime.h>
#include <cstdio>
#include <cstdint>

#define LAS __attribute__((address_space(3)))
typedef unsigned short bf16_t;
typedef short bf16x8 __attribute__((ext_vector_type(8)));
typedef float f32x4 __attribute__((ext_vector_type(4)));
typedef float f32x2 __attribute__((ext_vector_type(2)));
typedef unsigned u32x4 __attribute__((ext_vector_type(4)));
typedef unsigned u32x2 __attribute__((ext_vector_type(2)));

constexpr int D = 1024, NB = 8, SEQ = 2048, CTXL = 256, GWID = 64;
constexpr int MX = NB * SEQ, MC = NB * CTXL, MT = MX + MC;
constexpr int DFF = 2816, NFF = 2 * DFF;
constexpr int NH = 8, INW = 3104, INWP = 3328, ZW = 3072;
constexpr int NMOD = 6 * D;
constexpr float EPS = 1e-6f;
constexpr int NWAVES = 8, NTHREADS = 512;

constexpr size_t MiB = 1u << 20;
constexpr size_t WS_CTL = 0, CTL_ZERO_BYTES = 64 * 1024;
constexpr size_t WS_MOD = 1 * MiB;
constexpr size_t WS_XC = 2 * MiB;
constexpr size_t WS_WP = 10 * MiB;
constexpr size_t WS_WF1 = 11 * MiB;
constexpr size_t WS_WF2A = 11 * MiB;
constexpr size_t WS_FXP = 11 * MiB + 5632 * 1024;
constexpr size_t WS_H = 22 * MiB;
constexpr size_t WS_BIG = 58 * MiB;
constexpr size_t WS_UG0 = 58 * MiB;
constexpr size_t WS_Y0 = 58 * MiB;
constexpr size_t WS_WI = 58 * MiB;
constexpr size_t WS_WO = 65 * MiB;
constexpr size_t WS_WF2B = 67 * MiB;
constexpr size_t WS_Z = 73 * MiB;
constexpr size_t WS_Y1 = 73 * MiB;
constexpr size_t WS_GT = 181 * MiB;
constexpr size_t WS_HF = 187 * MiB;
constexpr size_t WS_HB = 219 * MiB;
constexpr size_t WS_UG1 = 80 * MiB;
constexpr size_t WS_END = 256 * MiB;
static_assert(WS_UG0 + (size_t)MT * NFF * 2 <= WS_END, "ug0");
static_assert(WS_UG1 + (size_t)MX * NFF * 2 <= WS_END, "ug1");
static_assert(WS_HB + (size_t)MX * D * 2 <= WS_END, "hb");
static_assert(WS_H + (size_t)MT * D * 2 <= WS_BIG, "h");
static_assert(WS_Z + (size_t)MT * ZW * 2 <= WS_GT, "z");
static_assert(WS_GT + (size_t)MT * 32 * 4 <= WS_HF, "gt");

enum { PH_P0 = 0, PH_POOL, PH_G1, PH_E2, PH_G2, PH_E3, PH_G3, PH_E4, PH_G4, PH_E5, PH_MLSTM, PH_E6, PH_G5, PH_E7, PH_G6, PH_E8, PH_G7, PH_E9, NPH };

struct P {
    const float* in[18];
    float* out;
    unsigned char* ws;
    int lo, hi;
};
enum { I_X = 0, I_C, I_CTX, I_CCTX, I_MODW, I_MODB, I_NORMG, I_POOLW, I_POOLS, I_MWIN, I_MBG, I_MCW, I_MCB, I_MWOUT, I_FWIN, I_FCW, I_FCB, I_FWOUT };

__device__ __forceinline__ unsigned f2bf(float f) { unsigned u = __builtin_bit_cast(unsigned, f); return (u + 0x7fffu + ((u >> 16) & 1u)) >> 16; }
__device__ __forceinline__ unsigned pk2(float lo, float hi) { return f2bf(lo) | (f2bf(hi) << 16); }
__device__ __forceinline__ float bf2f(unsigned short h) { return __builtin_bit_cast(float, (unsigned)h << 16); }
__device__ __forceinline__ float bflo(unsigned w) { return __builtin_bit_cast(float, w << 16); }
__device__ __forceinline__ float bfhi(unsigned w) { return __builtin_bit_cast(float, w & 0xffff0000u); }
__device__ __forceinline__ float wave_sum(float v) {
#pragma unroll
    for (int o = 1; o < 64; o <<= 1) v += __shfl_xor(v, o);
    return v;
}
__device__ __forceinline__ float silu_f(float x) { return x / (1.f + __expf(-x)); }
__device__ __forceinline__ float sigmoid_f(float x) { return 1.f / (1.f + __expf(-x)); }
__device__ __forceinline__ float logsigmoid_f(float x) { return fminf(x, 0.f) - log1pf(__expf(-fabsf(x))); }
__device__ __forceinline__ int mrow_of(int r) { return r < MX ? (r >> 11) : 8; }
#define LDS_WAIT() asm volatile("s_waitcnt lgkmcnt(0)" ::: "memory")

namespace pg8 {
constexpr int BM = 256, BK = 64, HALF = 128, HTB = HALF * BK * 2, STAGE_BYTES = 8 * HTB, NXCD = 8, WGM = 8;
__host__ __device__ __forceinline__ int lds_byte(int r, int c) { const int st = (r >> 4) * 2 + (c >> 5), rr = r & 15, cc = c & 31, ob = rr * 64 + cc * 2; return st * 1024 + (ob ^ (((ob >> 9) & 1) << 5)); }
__host__ __device__ __forceinline__ void stage_rc(int b, int& R, int& C) { const int st = b / 1024, sb = b % 1024, swz = sb ^ (((sb >> 9) & 1) << 5); R = (st >> 1) * 16 + swz / 64; C = (st & 1) * 32 + (swz % 64) / 2; }
__host__ __device__ __forceinline__ int perm32(int rho) { const int n = rho >> 4, i = rho & 15; return 8 * (i >> 2) + 4 * n + (i & 3); }
struct Unit { int pm, pn, k0, nt; };
struct Gemm { const bf16_t* A; const bf16_t* Bt; int M, N, K, lda, ldb, akoff; };
struct StaticOrder {
    int nM, nN, nwg, G, c, ntk;
    __host__ __device__ void init(int M, int N, int K, int G_, int c_) { nM = M / BM; nN = N / BM; nwg = nM * nN; G = G_; c = c_; ntk = K / BK; }
    __host__ __device__ bool next(int i, Unit& u) const {
        const long L = (long)i * G + c; if (L >= nwg) return false;
        int wgid = (int)L; { const int q = nwg / NXCD, r = nwg % NXCD, xcd = wgid % NXCD, off = wgid / NXCD; wgid = (xcd < r ? xcd * (q + 1) : r * (q + 1) + (xcd - r) * q) + off; }
        const int nig = WGM * nN, gid = wgid / nig, fm = gid * WGM, gsz = (nM - fm) < WGM ? (nM - fm) : WGM;
        u.pm = fm + ((wgid % nig) % gsz); u.pn = (wgid % nig) / gsz; u.k0 = 0; u.nt = ntk; return true;
    }
};
struct G3Order {
    StaticOrder S; int G, c;
    __host__ __device__ void init(int G_, int c_) { S.init(MX, D, DFF, G_, 0); G = G_; c = c_; }
    __host__ __device__ bool next(int i, Unit& u) const {
        const int L = i * G + c;
        if (L < 256) { StaticOrder T = S; T.c = L; T.G = 1 << 20; return T.next(0, u); }
        if (L < 320) { const int x = L - 256, kh = x & 1, t = x >> 1; u.pm = MX / BM + (t >> 2); u.pn = t & 3; u.k0 = kh * (DFF / BK / 2); u.nt = DFF / BK / 2; return true; }
        return false;
    }
};
__device__ __forceinline__ unsigned cvt_pk_bf16(float lo, float hi) { unsigned r; asm volatile("v_cvt_pk_bf16_f32 %0, %1, %2" : "=v"(r) : "v"(lo), "v"(hi)); return r; }

struct EpiF32 {
    static constexpr bool PERM = false;
    float* O; int ldc;
    __device__ __forceinline__ void operator()(const f32x4 (&acc)[2][2][4][2], const Unit& u, int wr, int wc, int fr, int fq) const {
        const int row0 = u.pm * BM + wr * 64 + fr, col0 = u.pn * BM + wc * 32 + 4 * fq;
#pragma unroll
        for (int ai = 0; ai < 2; ++ai)
#pragma unroll
            for (int m = 0; m < 4; ++m) { float* rowp = O + (size_t)(row0 + ai * HALF + m * 16) * ldc + col0;
#pragma unroll
                for (int bj = 0; bj < 2; ++bj)
#pragma unroll
                    for (int n = 0; n < 2; ++n) *(f32x4*)(rowp + bj * HALF + n * 16) = acc[ai][bj][m][n]; }
    }
};
struct EpiBf16 {
    static constexpr bool PERM = true;
    bf16_t* O; int ldc;
    __device__ __forceinline__ void operator()(const f32x4 (&acc)[2][2][4][2], const Unit& u, int wr, int wc, int fr, int fq) const {
        const int row0 = u.pm * BM + wr * 64 + fr, col0 = u.pn * BM + wc * 32 + 8 * fq;
#pragma unroll
        for (int ai = 0; ai < 2; ++ai)
#pragma unroll
            for (int m = 0; m < 4; ++m) { bf16_t* rowp = O + (size_t)(row0 + ai * HALF + m * 16) * ldc + col0;
#pragma unroll
                for (int bj = 0; bj < 2; ++bj) { const f32x4 v0 = acc[ai][bj][m][0], v1 = acc[ai][bj][m][1];
                    u32x4 w; w.x = cvt_pk_bf16(v0[0], v0[1]); w.y = cvt_pk_bf16(v0[2], v0[3]); w.z = cvt_pk_bf16(v1[0], v1[1]); w.w = cvt_pk_bf16(v1[2], v1[3]);
                    *(u32x4*)(rowp + bj * HALF) = w; } }
    }
};
struct EpiBf16Split {
    static constexpr bool PERM = true;
    bf16_t* O; bf16_t* O2; int ldc;
    __device__ __forceinline__ void operator()(const f32x4 (&acc)[2][2][4][2], const Unit& u, int wr, int wc, int fr, int fq) const {
        bf16_t* base = O; int pm = u.pm; if (u.k0 != 0) { base = O2; pm -= MX / BM; }
        const int row0 = pm * BM + wr * 64 + fr, col0 = u.pn * BM + wc * 32 + 8 * fq;
#pragma unroll
        for (int ai = 0; ai < 2; ++ai)
#pragma unroll
            for (int m = 0; m < 4; ++m) { bf16_t* rowp = base + (size_t)(row0 + ai * HALF + m * 16) * ldc + col0;
#pragma unroll
                for (int bj = 0; bj < 2; ++bj) { const f32x4 v0 = acc[ai][bj][m][0], v1 = acc[ai][bj][m][1];
                    u32x4 w; w.x = cvt_pk_bf16(v0[0], v0[1]); w.y = cvt_pk_bf16(v0[2], v0[3]); w.z = cvt_pk_bf16(v1[0], v1[1]); w.w = cvt_pk_bf16(v1[2], v1[3]);
                    *(u32x4*)(rowp + bj * HALF) = w; } }
    }
};
struct EpiZ {
    static constexpr bool PERM = true;
    bf16_t* Z; float* GT;
    __device__ __forceinline__ void operator()(const f32x4 (&acc)[2][2][4][2], const Unit& u, int wr, int wc, int fr, int fq) const {
        const int row0 = u.pm * BM + wr * 64 + fr;
        if (u.pn < 12) {
            const int col0 = u.pn * BM + wc * 32 + 8 * fq;
#pragma unroll
            for (int ai = 0; ai < 2; ++ai)
#pragma unroll
                for (int m = 0; m < 4; ++m) { bf16_t* rowp = Z + (size_t)(row0 + ai * HALF + m * 16) * ZW + col0;
#pragma unroll
                    for (int bj = 0; bj < 2; ++bj) { const f32x4 v0 = acc[ai][bj][m][0], v1 = acc[ai][bj][m][1];
                        u32x4 w; w.x = cvt_pk_bf16(v0[0], v0[1]); w.y = cvt_pk_bf16(v0[2], v0[3]); w.z = cvt_pk_bf16(v1[0], v1[1]); w.w = cvt_pk_bf16(v1[2], v1[3]);
                        *(u32x4*)(rowp + bj * HALF) = w; } }
        } else if (wc == 0) {
#pragma unroll
            for (int ai = 0; ai < 2; ++ai)
#pragma unroll
                for (int m = 0; m < 4; ++m) { float* rowp = GT + (size_t)(row0 + ai * HALF + m * 16) * 32 + 8 * fq;
                    *(f32x4*)(rowp) = acc[ai][0][m][0]; *(f32x4*)(rowp + 4) = acc[ai][0][m][1]; }
        }
    }
};

template <class Epi, class Sched, bool ALIGN_EPI>
__device__ __forceinline__ void gemm_phase(LAS unsigned char* lds, const Gemm g, const Sched& S, const Epi& E) {
    const int tid = threadIdx.x, wid = __builtin_amdgcn_readfirstlane(tid >> 6), lane = tid & 63, wr = wid >> 2, wc = wid & 3, fr = lane & 15, fq = lane >> 4;
    unsigned voffA[2], voffB[2];
#pragma unroll
    for (int i = 0; i < 2; ++i) { int R, C; stage_rc(tid * 16 + i * 8192, R, C); const int Rb = Epi::PERM ? ((R & ~31) + perm32(R & 31)) : R;
        voffA[i] = (unsigned)(R * g.lda + C) * 2u; voffB[i] = (unsigned)(Rb * g.ldb + C) * 2u; }
    const size_t kstep = (size_t)(BK * 2);
    const size_t hstepA = (size_t)HALF * g.lda * 2, hstepB = (size_t)HALF * g.ldb * 2;
    const size_t tstepA = 2 * hstepA, tstepB = 2 * hstepB;
    const size_t akoffb = (size_t)g.akoff * 2;
    const unsigned ldsw = (unsigned)wid * 1024u;
    const int aoff = lds_byte(wr * 64 + fr, fq * 8), boff = lds_byte(wc * 32 + fr, fq * 8);
#define PG8_SA(b, h) (((b) * 2 + (h)) * HTB)
#define PG8_SB(b, h) ((4 + (b) * 2 + (h)) * HTB)
#define PG8_STAGE(bufoff, gbase, voff) do { _Pragma("unroll") for (int _i = 0; _i < 2; ++_i) \
        __builtin_amdgcn_global_load_lds((const unsigned*)((const char*)(gbase) + (voff)[_i]), (LAS unsigned*)(lds + (bufoff) + ldsw + _i * 8192), 16, 0, 0); } while (0)
#define PG8_LDA(dst, b, h) do { _Pragma("unroll") for (int m = 0; m < 4; ++m) _Pragma("unroll") for (int k = 0; k < 2; ++k) dst[m][k] = *(const LAS bf16x8*)(lds + PG8_SA(b, h) + aoff + m * 2048 + k * 1024); } while (0)
#define PG8_LDB(dst, b, h) do { _Pragma("unroll") for (int n = 0; n < 2; ++n) _Pragma("unroll") for (int k = 0; k < 2; ++k) dst[n][k] = *(const LAS bf16x8*)(lds + PG8_SB(b, h) + boff + n * 2048 + k * 1024); } while (0)
#define PG8_MMA(ai, bj, At, Bt) do { __builtin_amdgcn_s_setprio(1); _Pragma("unroll") for (int m = 0; m < 4; ++m) _Pragma("unroll") for (int n = 0; n < 2; ++n) _Pragma("unroll") for (int k = 0; k < 2; ++k) \
        acc[ai][bj][m][n] = __builtin_amdgcn_mfma_f32_16x16x32_bf16(Bt[n][k], At[m][k], acc[ai][bj][m][n], 0, 0, 0); __builtin_amdgcn_s_setprio(0); } while (0)
#define PG8_WAIT_V(n) asm volatile("s_waitcnt vmcnt(" #n ")" ::: "memory")
#define PG8_WAIT_L(n) asm volatile("s_waitcnt lgkmcnt(" #n ")" ::: "memory")
#define PG8_BAR __builtin_amdgcn_s_barrier()
#define PG8_SCHED __builtin_amdgcn_sched_barrier(0)
    Unit cur, nxt; int ui = 0;
    if (!S.next(0, cur)) return;
    f32x4 acc[2][2][4][2];
#pragma unroll
    for (int a = 0; a < 2; ++a)
#pragma unroll
        for (int b = 0; b < 2; ++b)
#pragma unroll
            for (int m = 0; m < 4; ++m)
#pragma unroll
                for (int n = 0; n < 2; ++n) acc[a][b][m][n] = (f32x4){0.f, 0.f, 0.f, 0.f};
    bf16x8 At[4][2], B0[2][2], B1[2][2];
    const char* cA = (const char*)g.A + (size_t)cur.pm * tstepA + (size_t)cur.pn * akoffb + (size_t)cur.k0 * kstep; const char* cB = (const char*)g.Bt + (size_t)cur.pn * tstepB + (size_t)cur.k0 * kstep;
    PG8_STAGE(PG8_SB(0, 0), cB, voffB); PG8_STAGE(PG8_SB(0, 1), cB + hstepB, voffB); PG8_STAGE(PG8_SA(0, 0), cA, voffA); PG8_STAGE(PG8_SA(0, 1), cA + hstepA, voffA);
    if (wr == 1) PG8_BAR;
    PG8_WAIT_V(2); PG8_BAR;
    PG8_STAGE(PG8_SB(1, 0), cB + kstep, voffB); PG8_STAGE(PG8_SA(1, 0), cA + kstep, voffA); PG8_STAGE(PG8_SB(1, 1), cB + hstepB + kstep, voffB);
    PG8_WAIT_V(6); PG8_BAR;
    for (;;) {
        const bool has_next = S.next(ui + 1, nxt);
        const char* nA = has_next ? (const char*)g.A + (size_t)nxt.pm * tstepA + (size_t)nxt.pn * akoffb + (size_t)nxt.k0 * kstep : cA; const char* nB = has_next ? (const char*)g.Bt + (size_t)nxt.pn * tstepB + (size_t)nxt.k0 * kstep : cB;
        const int nt = cur.nt;
        for (int t = 0; t < nt; t += 2) {
            const bool last = (t == nt - 2);
            const char* a1 = cA + (size_t)(t + 1) * kstep;
            const char* a2 = last ? nA : cA + (size_t)(t + 2) * kstep; const char* b2 = last ? nB : cB + (size_t)(t + 2) * kstep;
            const char* a3 = a2 + kstep; const char* b3 = b2 + kstep;
            PG8_LDB(B0, 0, 0); PG8_LDB(B1, 0, 1); PG8_SCHED; PG8_LDA(At, 0, 0); PG8_STAGE(PG8_SA(1, 1), a1 + hstepA, voffA);
            PG8_WAIT_V(8); PG8_WAIT_L(0); PG8_BAR; PG8_MMA(0, 0, At, B0); PG8_MMA(0, 1, At, B1); PG8_BAR; PG8_SCHED;
            PG8_LDA(At, 0, 1); PG8_STAGE(PG8_SB(0, 0), b2, voffB); PG8_STAGE(PG8_SB(0, 1), b2 + hstepB, voffB); PG8_STAGE(PG8_SA(0, 0), a2, voffA);
            PG8_WAIT_V(8); PG8_WAIT_L(0); PG8_BAR; PG8_MMA(1, 0, At, B0); PG8_MMA(1, 1, At, B1); PG8_BAR; PG8_SCHED;
            PG8_LDB(B0, 1, 0); PG8_LDB(B1, 1, 1); PG8_SCHED; PG8_LDA(At, 1, 0); PG8_STAGE(PG8_SA(0, 1), a2 + hstepA, voffA);
            PG8_WAIT_V(8); PG8_WAIT_L(0); PG8_BAR; PG8_MMA(0, 0, At, B0); PG8_MMA(0, 1, At, B1); PG8_BAR; PG8_SCHED;
            PG8_LDA(At, 1, 1); PG8_STAGE(PG8_SB(1, 0), b3, voffB); PG8_STAGE(PG8_SB(1, 1), b3 + hstepB, voffB); PG8_STAGE(PG8_SA(1, 0), a3, voffA);
            PG8_WAIT_V(8); PG8_WAIT_L(0); PG8_BAR; PG8_MMA(1, 0, At, B0); PG8_MMA(1, 1, At, B1); PG8_BAR; PG8_SCHED;
        }
        if constexpr (ALIGN_EPI) { if (wr == 0) PG8_BAR; }
        E(acc, cur, wr, wc, fr, fq);
        if (!has_next) break;
#pragma unroll
        for (int a = 0; a < 2; ++a)
#pragma unroll
            for (int b = 0; b < 2; ++b)
#pragma unroll
                for (int m = 0; m < 4; ++m)
#pragma unroll
                    for (int n = 0; n < 2; ++n) acc[a][b][m][n] = (f32x4){0.f, 0.f, 0.f, 0.f};
        cur = nxt; cA = nA; cB = nB; ++ui;
        if constexpr (ALIGN_EPI) { if (wr == 1) PG8_BAR; }
    }
    PG8_WAIT_V(0);
    if constexpr (!ALIGN_EPI) { if (wr == 0) PG8_BAR; }
    PG8_BAR;
#undef PG8_SA
#undef PG8_SB
#undef PG8_STAGE
#undef PG8_LDA
#undef PG8_LDB
#undef PG8_MMA
#undef PG8_WAIT_V
#undef PG8_WAIT_L
#undef PG8_BAR
#undef PG8_SCHED
}
}

constexpr int RING_OFF = 0, RING_BYTES = 131072;
constexpr int LDSCTL_OFF = RING_BYTES, MISC_OFF = LDSCTL_OFF + 320;
constexpr int LDS_BYTES = 147456;
constexpr int CW_BAR = 4096;
#define XB_TMO      128
#define XB_XCNT(j)  (256  + 64 * (j))
#define XB_XSUB(j)  (1280 + 64 * (j))
#define XB_XGEN(j)  (2304 + 64 * (j))
#define XB_TOP      3328
#define XB_TOPGEN   3392
#define XCD_BAR_WORDS 3456
#define XB_SPIN_CAP (1u << 18)
__device__ __forceinline__ unsigned xb_ld(unsigned* p)              { return __hip_atomic_load(p, __ATOMIC_RELAXED, __HIP_MEMORY_SCOPE_AGENT); }
__device__ __forceinline__ unsigned xb_add(unsigned* p, unsigned v) { return __hip_atomic_fetch_add(p, v, __ATOMIC_RELAXED, __HIP_MEMORY_SCOPE_AGENT); }
__device__ __forceinline__ unsigned xb_xcc_id() { return (unsigned)__builtin_amdgcn_s_getreg((3 << 11) | 20) & 0xFu; }
#define XB_SPIN(cond, bar) do { unsigned _sp = 0; while (cond) { __builtin_amdgcn_s_sleep(1); \
    if ((++_sp & 255u) == 0u) { if (xb_ld(&(bar)[XB_TMO])) break; if (_sp > XB_SPIN_CAP) { atomicAdd(&(bar)[XB_TMO], 1u); break; } } } } while (0)
struct XcdBarrier { unsigned* bar; unsigned x; volatile LAS unsigned* st; };
__device__ __forceinline__ XcdBarrier xcd_barrier_post(unsigned* bar, volatile LAS unsigned* st) {
    XcdBarrier b; b.bar = bar; b.x = xb_xcc_id(); b.st = st;
    if (threadIdx.x == 0) (void)xb_add(&bar[XB_XCNT(b.x)], 1u);
    return b;
}
__device__ __forceinline__ void xcd_barrier_complete(unsigned* bar, unsigned x, unsigned& nloc, unsigned& nx) {
    const unsigned G = gridDim.x * gridDim.y * gridDim.z;
    unsigned sum, cnt, mine, sp = 0u;
    for (;;) {
        sum = 0u; cnt = 0u; mine = 0u;
#pragma unroll
        for (unsigned j = 0; j < 16; ++j) { const unsigned c = xb_ld(&bar[XB_XCNT(j)]); sum += c; cnt += (c > 0u) ? 1u : 0u; mine = (j == x) ? c : mine; }
        if (sum == G) break;
        __builtin_amdgcn_s_sleep(1);
        if ((++sp & 255u) == 0u) { if (xb_ld(&bar[XB_TMO])) break; if (sp > XB_SPIN_CAP) { atomicAdd(&bar[XB_TMO], 1u); break; } }
    }
    nloc = mine > 0u ? mine : 1u; nx = cnt > 0u ? cnt : 1u;
}
__device__ __forceinline__ void xcd_barrier(const XcdBarrier& b) {
    asm volatile("s_waitcnt vmcnt(0)" ::: "memory");
    __syncthreads();
    if (threadIdx.x == 0) {
        unsigned* bar = b.bar;
        __builtin_amdgcn_s_waitcnt(0);
        unsigned nloc = b.st[0], nx = b.st[1];
        if (nloc == 0u) { xcd_barrier_complete(bar, b.x, nloc, nx); b.st[0] = nloc; b.st[1] = nx; }
        const unsigned old = xb_add(&bar[XB_XSUB(b.x)], 1u);
        const unsigned gen = old / nloc;
        if (old + 1u == (gen + 1u) * nloc) {
            __builtin_amdgcn_fence(__ATOMIC_RELEASE, "agent");
            asm volatile("s_waitcnt vmcnt(0)" ::: "memory");
            const unsigned og = xb_add(&bar[XB_TOP], 1u);
            const unsigned tg = og / nx;
            if (og + 1u == (tg + 1u) * nx) xb_add(&bar[XB_TOPGEN], 1u);
            else XB_SPIN(xb_ld(&bar[XB_TOPGEN]) == tg, bar);
            __builtin_amdgcn_fence(__ATOMIC_ACQUIRE, "agent");
            xb_add(&bar[XB_XGEN(b.x)], 1u);
            asm volatile("s_waitcnt vmcnt(0)" ::: "memory");
        } else {
            XB_SPIN(xb_ld(&bar[XB_XGEN(b.x)]) == gen, bar);
            __builtin_amdgcn_fence(__ATOMIC_ACQUIRE, "agent");
            asm volatile("s_waitcnt vmcnt(0)" ::: "memory");
        }
    }
    __syncthreads();
}

struct Frame {
    LAS unsigned char* lds;
    int tid, lane, wave, vcu, G, gw, NGW;
    const float* in[18];
    float* out; unsigned char* ws;
};
__device__ __forceinline__ const float* src_row(const Frame& F, int r) {
    return r < MX ? F.in[I_X] + (size_t)r * D : F.in[I_CTX] + (size_t)(r - MX) * D;
}
__device__ __forceinline__ float* stream_row(const Frame& F, int r) {
    return r < MX ? F.out + (size_t)r * D : (float*)(F.ws + WS_XC) + (size_t)(r - MX) * D;
}
__device__ __forceinline__ const float* modp(const Frame& F, int layer, int mrow, int idx) {
    return (const float*)(F.ws + WS_MOD) + ((size_t)(layer * 9 + mrow) * NMOD + idx * D);
}
__device__ __forceinline__ void ld_row(const float* p, int lane, f32x4 (&v)[4]) {
#pragma unroll
    for (int j = 0; j < 4; ++j) v[j] = ((const f32x4*)p)[64 * j + lane];
}
__device__ __forceinline__ void st_row(float* p, int lane, const f32x4 (&v)[4]) {
#pragma unroll
    for (int j = 0; j < 4; ++j) ((f32x4*)p)[64 * j + lane] = v[j];
}
__device__ __forceinline__ void ld_row_bf(const bf16_t* p, int lane, f32x4 (&v)[4]) {
#pragma unroll
    for (int j = 0; j < 4; ++j) { const u32x2 w = ((const u32x2*)p)[64 * j + lane]; v[j] = (f32x4){bflo(w.x), bfhi(w.x), bflo(w.y), bfhi(w.y)}; }
}
__device__ __forceinline__ void st_row_bf(bf16_t* p, int lane, const f32x4 (&v)[4]) {
#pragma unroll
    for (int j = 0; j < 4; ++j) { u32x2 w; w.x = pk2(v[j][0], v[j][1]); w.y = pk2(v[j][2], v[j][3]); ((u32x2*)p)[64 * j + lane] = w; }
}
__device__ __forceinline__ float sumsq(const f32x4 (&v)[4]) {
    float s = 0.f;
#pragma unroll
    for (int j = 0; j < 4; ++j) s += (v[j][0] * v[j][0] + v[j][1] * v[j][1]) + (v[j][2] * v[j][2] + v[j][3] * v[j][3]);
    return s;
}
__device__ __forceinline__ void modulate_row_bf(const f32x4 (&x)[4], float rstd, const float* g, const float* sc, const float* sh, int lane, bf16_t* o) {
    f32x4 gv[4], scv[4], shv[4], h[4];
    ld_row(g, lane, gv); ld_row(sc, lane, scv); ld_row(sh, lane, shv);
#pragma unroll
    for (int j = 0; j < 4; ++j) h[j] = x[j] * rstd * gv[j] * (scv[j] + 1.f) + shv[j];
    st_row_bf(o, lane, h);
}

__device__ __forceinline__ void transpose_item(const float* W, int K, int N, bf16_t* WT, int row_off, LAS float* scr, int item, int lane) {
    const int nblk = N / 32, kb = item / nblk, nb = item % nblk, k0 = 64 * kb, n0 = 32 * nb;
#pragma unroll 8
    for (int i = 0; i < 32; ++i) { const int kk = 2 * i + (lane >> 5); scr[kk * 33 + (lane & 31)] = W[(size_t)(k0 + kk) * N + n0 + (lane & 31)]; }
    LDS_WAIT(); asm volatile("" ::: "memory");
    const int c = lane & 7;
#pragma unroll
    for (int j = 0; j < 4; ++j) { const int n = (lane >> 3) + 8 * j; const LAS float* s = scr + (8 * c) * 33 + n;
        u32x4 o; o.x = pk2(s[0 * 33], s[1 * 33]); o.y = pk2(s[2 * 33], s[3 * 33]); o.z = pk2(s[4 * 33], s[5 * 33]); o.w = pk2(s[6 * 33], s[7 * 33]);
        *(u32x4*)(WT + (size_t)(row_off + n0 + n) * K + k0 + 8 * c) = o; }
    LDS_WAIT(); asm volatile("" ::: "memory");
}

__device__ __forceinline__ void ph_p0(Frame& F) {
    LAS float* S = (LAS float*)(F.lds);
    LAS float* red = (LAS float*)(F.lds + 9 * 1024 * 4);
    if (F.vcu < 192) {
        for (int i = F.tid; i < 9 * 1024; i += NTHREADS) { const int r = i >> 10, k = i & 1023; const float c = r < 8 ? F.in[I_C][r * D + k] : F.in[I_CCTX][k]; S[i] = silu_f(c); }
        __syncthreads();
        for (int it = F.vcu; it < 192; it += F.G) {
            const int l = it / 96, j0 = (it % 96) * 64;
            const float* W = F.in[I_MODW] + (size_t)l * D * NMOD + j0 + F.lane;
            float acc[9];
#pragma unroll
            for (int r = 0; r < 9; ++r) acc[r] = 0.f;
            const int kb = F.wave * 128;
#pragma unroll 1
            for (int k0 = 0; k0 < 128; k0 += 32) { float wv[32];
#pragma unroll
                for (int k = 0; k < 32; ++k) wv[k] = W[(size_t)(kb + k0 + k) * NMOD];
#pragma unroll
                for (int k = 0; k < 32; ++k) {
#pragma unroll
                    for (int r = 0; r < 9; ++r) acc[r] += S[r * 1024 + kb + k0 + k] * wv[k]; } }
#pragma unroll
            for (int r = 0; r < 9; ++r) red[(F.wave * 9 + r) * 64 + F.lane] = acc[r];
            __syncthreads();
            for (int i = F.tid; i < 9 * 64; i += NTHREADS) { const int r = i >> 6, ln = i & 63; float s = F.in[I_MODB][l * NMOD + j0 + ln];
#pragma unroll
                for (int w = 0; w < 8; ++w) s += red[(w * 9 + r) * 64 + ln];
                ((float*)(F.ws + WS_MOD))[(size_t)(l * 9 + r) * NMOD + j0 + ln] = s; }
            __syncthreads();
        }
    }
    __syncthreads();
    LAS float* scr = (LAS float*)(F.lds + 55296 + F.wave * 8448);
    constexpr int I_P = (256 / 64) * (256 / 32);
    constexpr int I_F1 = (D / 64) * (NFF / 32);
    constexpr int NIT = 4 * I_P + I_F1;
    for (int it = F.gw; it < NIT; it += F.NGW) {
        int r = it;
        if (r < 4 * I_P) { const int g = r / I_P; transpose_item(F.in[I_POOLW] + (size_t)g * 256 * 256, 256, 256, (bf16_t*)(F.ws + WS_WP), g * 256, scr, r % I_P, F.lane); continue; } r -= 4 * I_P;
        transpose_item(F.in[I_FWIN], D, NFF, (bf16_t*)(F.ws + WS_WF1), 0, scr, r, F.lane);
    }
}

template <int GI>
__device__ __forceinline__ void pool_thread(const Frame& F, int R0, int W, int p0, int ps, const LAS float* rs, f32x2 cm, f32x2 shv, int c, bf16_t* YP) {
    constexpr int win = 2 << GI, hw = win / 2, NV = 16 + 2 * hw;
#pragma unroll 1
    for (int blk = 0; blk < 4; ++blk) {
        const int pb = p0 + 16 * blk;
        f32x2 hv[NV];
#pragma unroll
        for (int k = 0; k < NV; ++k) { const int qp = pb - hw + k; const int qc = qp < 0 ? 0 : (qp >= W ? W - 1 : qp);
            hv[k] = *(const f32x2*)(src_row(F, R0 + qc) + c); }
#pragma unroll
        for (int k = 0; k < NV; ++k) { const int qp = pb - hw + k; const int qc = qp < 0 ? 0 : (qp >= W ? W - 1 : qp);
            const float r = rs[qc - ps]; const f32x2 h = hv[k] * r * cm + shv; hv[k] = (qp == qc) ? h : (f32x2){0.f, 0.f}; }
#pragma unroll
        for (int j = 0; j < 16; ++j) { const int pp = pb + j;
            f32x2 sm = hv[j];
#pragma unroll
            for (int t = 1; t < win; ++t) sm += hv[j + t];
            int lo = pp - hw; lo = lo < 0 ? 0 : lo; int hi = pp + hw; hi = hi > W ? W : hi;
            const float inv = 1.f / (float)(hi - lo); const f32x2 o = sm * inv - hv[j + hw];
            *(unsigned*)(YP + (size_t)(R0 + pp) * D + c) = pk2(o.x, o.y); }
    }
}
__device__ __forceinline__ void ph_pool(Frame& F) {
    LAS float* rs = (LAS float*)(F.lds);
    bf16_t* YP = (bf16_t*)(F.ws + WS_H);
    const float* g0 = F.in[I_NORMG];
    const int c = 2 * F.tid, gi = F.tid >> 7;
    for (int ti = F.vcu; ti < 288; ti += F.G) {
        int R0, W, p0, mrow;
        if (ti < 256) { R0 = ti * 64; W = 64; p0 = 0; mrow = ti >> 5; }
        else { const int cb = (ti - 256) >> 2, seg = (ti - 256) & 3; R0 = MX + cb * 256; W = 256; p0 = seg * 64; mrow = 8; }
        const int ps = p0 - 8 > 0 ? p0 - 8 : 0, pe = p0 + 72 < W ? p0 + 72 : W, nl = pe - ps;
#pragma unroll 1
        for (int kb = 0; kb < 10; kb += 5) { f32x4 v[5][4];
#pragma unroll
          for (int k = 0; k < 5; ++k) { const int i = F.wave + 8 * (kb + k); if (i < nl) ld_row(src_row(F, R0 + ps + i), F.lane, v[k]); }
#pragma unroll
          for (int k = 0; k < 5; ++k) { const int i = F.wave + 8 * (kb + k); if (i < nl) { const float ss = wave_sum(sumsq(v[k])); if (F.lane == 0) rs[i] = rsqrtf(ss * (1.f / D) + EPS); } } }
        __syncthreads();
        const f32x2 gv = *(const f32x2*)(g0 + c), scv = *(const f32x2*)(modp(F, 0, mrow, 1) + c), shv = *(const f32x2*)(modp(F, 0, mrow, 0) + c);
        const f32x2 cm = gv * (scv + 1.f);
        if (gi == 0) pool_thread<0>(F, R0, W, p0, ps, rs, cm, shv, c, YP);
        else if (gi == 1) pool_thread<1>(F, R0, W, p0, ps, rs, cm, shv, c, YP);
        else if (gi == 2) pool_thread<2>(F, R0, W, p0, ps, rs, cm, shv, c, YP);
        else pool_thread<3>(F, R0, W, p0, ps, rs, cm, shv, c, YP);
        __syncthreads();
    }
}

struct RowVecs { f32x4 ps[4], cg[4], cm[4], sh[4]; };
template <bool PS, bool HOUT>
__device__ __forceinline__ void row_vecs(const Frame& F, RowVecs& V, const float* gy, const float* gate, const float* g2, const float* sc, const float* sh) {
    f32x4 a[4], b[4];
    ld_row(gy, F.lane, a); ld_row(gate, F.lane, b);
#pragma unroll
    for (int j = 0; j < 4; ++j) V.cg[j] = a[j] * b[j];
    if (PS) ld_row(F.in[I_POOLS], F.lane, V.ps);
    if (HOUT) { ld_row(g2, F.lane, a); ld_row(sc, F.lane, b); ld_row(sh, F.lane, V.sh);
#pragma unroll
        for (int j = 0; j < 4; ++j) V.cm[j] = a[j] * (b[j] + 1.f); }
}
template <bool YBF>
__device__ __forceinline__ void ld_y(const void* Y, int r, int lane, f32x4 (&y)[4]) {
    if (YBF) ld_row_bf((const bf16_t*)Y + (size_t)r * D, lane, y); else ld_row((const float*)Y + (size_t)r * D, lane, y);
}
template <bool PS, bool HOUT>
__device__ __forceinline__ void row_core(const Frame& F, const RowVecs& V, f32x4 (&y)[4], f32x4 (&x)[4], float* xout, bf16_t* hout) {
    if (PS) {
#pragma unroll
        for (int j = 0; j < 4; ++j) y[j] = y[j] * V.ps[j]; }
    const float rstd = rsqrtf(wave_sum(sumsq(y)) * (1.f / D) + EPS);
#pragma unroll
    for (int j = 0; j < 4; ++j) x[j] = x[j] + V.cg[j] * (y[j] * rstd);
    st_row(xout, F.lane, x);
    if (HOUT) {
        const float rstd2 = rsqrtf(wave_sum(sumsq(x)) * (1.f / D) + EPS);
        f32x4 h[4];
#pragma unroll
        for (int j = 0; j < 4; ++j) h[j] = x[j] * rstd2 * V.cm[j] + V.sh[j];
        st_row_bf(hout, F.lane, h);
    }
}
template <bool YBF, bool PS, bool HOUT, bool SRC, bool WITH_CTX>
__device__ __forceinline__ void row_pass(const Frame& F, const void* Y, const float* gy, int lg, int ig, const float* g2, int lm, int isc, int ish, bf16_t* H, const bf16_t* Y2c = nullptr) {
    for (int wv = F.gw; wv < 2048; wv += F.NGW) {
        RowVecs V;
        {
            const int mr = wv >> 8, r0 = wv * 8;
            row_vecs<PS, HOUT>(F, V, gy, modp(F, lg, mr, ig), g2, HOUT ? modp(F, lm, mr, isc) : nullptr, HOUT ? modp(F, lm, mr, ish) : nullptr);
            f32x4 y[4], x[4], yn[4], xn[4];
            ld_y<YBF>(Y, r0, F.lane, y); ld_row(SRC ? src_row(F, r0) : stream_row(F, r0), F.lane, x);
#pragma unroll 1
            for (int i = 0; i < 8; ++i) {
                const int r = r0 + i;
                if (i < 7) { ld_y<YBF>(Y, r + 1, F.lane, yn); ld_row(SRC ? src_row(F, r + 1) : stream_row(F, r + 1), F.lane, xn); }
                row_core<PS, HOUT>(F, V, y, x, stream_row(F, r), HOUT ? H + (size_t)r * D : nullptr);
#pragma unroll
                for (int j = 0; j < 4; ++j) { y[j] = yn[j]; x[j] = xn[j]; }
            }
        }
        if (WITH_CTX) {
            const int r = MX + wv;
            row_vecs<PS, HOUT>(F, V, gy, modp(F, lg, 8, ig), g2, HOUT ? modp(F, lm, 8, isc) : nullptr, HOUT ? modp(F, lm, 8, ish) : nullptr);
            f32x4 y[4], x[4];
            ld_y<YBF>(Y, r, F.lane, y); ld_row(SRC ? src_row(F, r) : stream_row(F, r), F.lane, x);
            if (Y2c) { f32x4 y2[4]; ld_row_bf(Y2c + (size_t)wv * D, F.lane, y2);
#pragma unroll
                for (int j = 0; j < 4; ++j) y[j] = y[j] + y2[j]; }
            row_core<PS, HOUT>(F, V, y, x, stream_row(F, r), HOUT ? H + (size_t)r * D : nullptr);
        }
    }
}
__device__ __forceinline__ void ph_e2(Frame& F) {
    const float* ng = F.in[I_NORMG];
    row_pass<true, true, true, true, true>(F, F.ws + WS_Y0, ng + 1 * D, 0, 2, ng + 2 * D, 0, 4, 3, (bf16_t*)(F.ws + WS_H));
}
__device__ __forceinline__ void ph_e4(Frame& F) {
    const float* ng = F.in[I_NORMG];
    row_pass<true, false, true, false, true>(F, F.ws + WS_H, ng + 3 * D, 0, 5, ng + 4 * D, 1, 1, 0, (bf16_t*)(F.ws + WS_H), (const bf16_t*)(F.ws + WS_FXP));
    LAS float* scr = (LAS float*)(F.lds + F.wave * 8448);
    constexpr int I_WI = (D / 64) * (INW / 32), I_WO = (D / 64) * (D / 32), I_F2 = (DFF / 64) * (D / 32), I_ZP = (INWP - INW);
    constexpr int NIT = I_WI + I_WO + I_F2 + I_ZP;
    for (int it = F.gw; it < NIT; it += F.NGW) {
        int r = it;
        if (r < I_WI) { transpose_item(F.in[I_MWIN], D, INW, (bf16_t*)(F.ws + WS_WI), 0, scr, r, F.lane); continue; } r -= I_WI;
        if (r < I_WO) { transpose_item(F.in[I_MWOUT], D, D, (bf16_t*)(F.ws + WS_WO), 0, scr, r, F.lane); continue; } r -= I_WO;
        if (r < I_F2) { transpose_item(F.in[I_FWOUT] + (size_t)DFF * D, DFF, D, (bf16_t*)(F.ws + WS_WF2B), 0, scr, r, F.lane); continue; } r -= I_F2;
        { u32x4* row = (u32x4*)((bf16_t*)(F.ws + WS_WI) + (size_t)(INW + r) * D); row[F.lane] = (u32x4){0u, 0u, 0u, 0u}; row[64 + F.lane] = (u32x4){0u, 0u, 0u, 0u}; }
    }
}
__device__ __forceinline__ void ph_e7(Frame& F) {
    const float* ng = F.in[I_NORMG] + 4 * D;
    row_pass<true, false, true, false, false>(F, F.ws + WS_Y1, ng + 1 * D, 1, 2, ng + 2 * D, 1, 4, 3, (bf16_t*)(F.ws + WS_H));
}
__device__ __forceinline__ void ph_e9(Frame& F) {
    const float* ng = F.in[I_NORMG] + 4 * D;
    row_pass<true, false, false, false, false>(F, F.ws + WS_H, ng + 3 * D, 1, 5, nullptr, 0, 0, 0, nullptr);
}

__device__ __forceinline__ void conv8(const bf16_t* src, int sld, int r, int c, const float* w, int wld, float (&acc)[8]) {
    int a_lo, a_hi, jj, Wd;
    if (r < MX) { const int n = r & (SEQ - 1), i = n >> 6; jj = n & 63; Wd = 64; a_lo = i > 0 ? 0 : 1; a_hi = i < 31 ? 2 : 1; }
    else { jj = (r - MX) & 255; Wd = 256; a_lo = 1; a_hi = 1; }
    const int b_lo = jj > 0 ? 0 : 1, b_hi = jj < Wd - 1 ? 2 : 1;
    for (int a = a_lo; a <= a_hi; ++a)
        for (int b = b_lo; b <= b_hi; ++b) {
            const int rn = r + (a - 1) * 64 + (b - 1);
            const u32x4 gv = *(const u32x4*)(src + (size_t)rn * sld + c);
            const float* wp = w + (a * 3 + b) * wld + c; const f32x4 w0 = *(const f32x4*)wp, w1 = *(const f32x4*)(wp + 4);
            acc[0] += bflo(gv.x) * w0[0]; acc[1] += bfhi(gv.x) * w0[1]; acc[2] += bflo(gv.y) * w0[2]; acc[3] += bfhi(gv.y) * w0[3];
            acc[4] += bflo(gv.z) * w1[0]; acc[5] += bfhi(gv.z) * w1[1]; acc[6] += bflo(gv.w) * w1[2]; acc[7] += bfhi(gv.w) * w1[3];
        }
}

__device__ __forceinline__ void conv_fetch(const Frame& F, const bf16_t* src, int sld, int nch, int task, int nxt, u32x4 (&gp)[6]) {
    const int chunk = task % nch, bd = task / nch;
    int r0; bool top_ok, bot_ok;
    if (bd < nxt) { r0 = bd * 256; const int i0 = (bd & 7) * 4; top_ok = i0 > 0; bot_ok = i0 + 4 < 32; }
    else { r0 = MX + (bd - nxt) * 256; top_ok = false; bot_ok = false; }
    const bf16_t* gsrc = src + chunk * 64 + (F.lane & 7) * 8 + (size_t)(r0 + 8 * F.wave + (F.lane >> 3)) * sld;
#pragma unroll
    for (int ir = 0; ir < 6; ++ir) {
        const bool ok = (ir == 0) ? top_ok : ((ir == 5) ? bot_ok : true);
        gp[ir] = ok ? *(const u32x4*)(gsrc + (ptrdiff_t)(ir - 1) * 64 * sld) : (u32x4){0u, 0u, 0u, 0u};
    }
}
__device__ __forceinline__ void conv_put(const Frame& F, LAS unsigned char* buf, const u32x4 (&gp)[6]) {
#pragma unroll
    for (int ir = 0; ir < 6; ++ir) *(LAS u32x4*)(buf + ir * 8192 + F.wave * 1024 + F.lane * 16) = gp[ir];
}
template <int MODE>
__device__ __forceinline__ void ph_conv(Frame& F, const bf16_t* src, int sld, int nch, bf16_t* UO, int old, const float* cw, int cwld, const float* cb, int M) {
    const int nxt = MX / 256;
    const int nbands = M / 256, ntask = nbands * nch;
    const int cg = F.tid & 7, j = F.tid >> 3;
    u32x4 gp[6];
    int task = F.vcu;
    if (task < ntask) { conv_fetch(F, src, sld, nch, task, nxt, gp); conv_put(F, F.lds, gp); }
    __syncthreads();
    int par = 0;
    for (; task < ntask; task += F.G, par ^= 1) {
        const bool has_next = task + F.G < ntask;
        const LAS unsigned char* buf = F.lds + par * 49152;
        const int chunk = task % nch, bd = task / nch;
        const bool isctx = bd >= nxt;
        const int r0 = isctx ? MX + (bd - nxt) * 256 : bd * 256;
        const int c = chunk * 64 + cg * 8;
        f32x4 wl[9][2];
#pragma unroll
        for (int t = 0; t < 9; ++t) { wl[t][0] = *(const f32x4*)(cw + t * cwld + c); wl[t][1] = *(const f32x4*)(cw + t * cwld + c + 4); }
        const f32x4 b0 = *(const f32x4*)(cb + c), b1 = *(const f32x4*)(cb + c + 4);
        u32x4 uv[4];
        if (MODE == 0) {
#pragma unroll
            for (int ir = 0; ir < 4; ++ir) uv[ir] = *(const u32x4*)(UO + (size_t)(r0 + ir * 64 + j) * old + c); }
        if (has_next) conv_fetch(F, src, sld, nch, task + F.G, nxt, gp);
        const bool lok = isctx || j > 0, rok = isctx || j < 63;
        u32x4 win[3][3];
        const u32x4 z4 = (u32x4){0u, 0u, 0u, 0u};
#define CONV_LD(dst, irow, lk, rk) do { const LAS unsigned char* p_ = buf + ((irow) * 64 + j) * 128 + cg * 16; \
            dst[1] = *(const LAS u32x4*)p_; dst[0] = (lk) ? *(const LAS u32x4*)(p_ - 128) : z4; dst[2] = (rk) ? *(const LAS u32x4*)(p_ + 128) : z4; } while (0)
        CONV_LD(win[0], 0, lok && !isctx, rok); CONV_LD(win[1], 1, lok, rok);
#pragma unroll
        for (int ir = 0; ir < 4; ++ir) {
            if (ir < 3) CONV_LD(win[(ir + 2) % 3], ir + 2, lok, rok); else CONV_LD(win[(ir + 2) % 3], ir + 2, lok, rok && !isctx);
            f32x4 a0 = b0, a1 = b1;
#pragma unroll
            for (int a = 0; a < 3; ++a) {
                if (isctx && a != 1) continue;
#pragma unroll
                for (int b = 0; b < 3; ++b) {
                    const u32x4 gv = win[(ir + a) % 3][b];
                    const f32x4 g0 = (f32x4){bflo(gv.x), bfhi(gv.x), bflo(gv.y), bfhi(gv.y)}, g1 = (f32x4){bflo(gv.z), bfhi(gv.z), bflo(gv.w), bfhi(gv.w)};
                    a0 += g0 * wl[a * 3 + b][0]; a1 += g1 * wl[a * 3 + b][1];
                }
            }
            u32x4 o;
            if (MODE == 0) { const u32x4 u4 = uv[ir];
                o.x = pk2(silu_f(a0[0]) * bflo(u4.x), silu_f(a0[1]) * bfhi(u4.x)); o.y = pk2(silu_f(a0[2]) * bflo(u4.y), silu_f(a0[3]) * bfhi(u4.y));
                o.z = pk2(silu_f(a1[0]) * bflo(u4.z), silu_f(a1[1]) * bfhi(u4.z)); o.w = pk2(silu_f(a1[2]) * bflo(u4.w), silu_f(a1[3]) * bfhi(u4.w));
            } else { const float sc = c >= 512 ? 0.125f : 1.f;
                o.x = pk2(silu_f(a0[0]) * sc, silu_f(a0[1]) * sc); o.y = pk2(silu_f(a0[2]) * sc, silu_f(a0[3]) * sc);
                o.z = pk2(silu_f(a1[0]) * sc, silu_f(a1[1]) * sc); o.w = pk2(silu_f(a1[2]) * sc, silu_f(a1[3]) * sc); }
            *(u32x4*)(UO + (size_t)(r0 + ir * 64 + j) * old + c) = o;
        }
#undef CONV_LD
        if (has_next) conv_put(F, F.lds + (par ^ 1) * 49152, gp);
        __syncthreads();
    }
}
__device__ __forceinline__ void ph_e3(Frame& F) {
    { bf16_t* UG = (bf16_t*)(F.ws + WS_UG0); ph_conv<0>(F, UG + DFF, NFF, 44, UG, NFF, F.in[I_FCW], DFF, F.in[I_FCB], MT); }
    LAS float* scr = (LAS float*)(F.lds + F.wave * 8448);
    constexpr int I_F2 = (DFF / 64) * (D / 32);
    for (int it = F.gw; it < I_F2; it += F.NGW) transpose_item(F.in[I_FWOUT], DFF, D, (bf16_t*)(F.ws + WS_WF2A), 0, scr, it, F.lane);
}
__device__ __forceinline__ void ph_e5(Frame& F) {
    float* GT = (float*)(F.ws + WS_GT);
    ph_conv<1>(F, (const bf16_t*)(F.ws + WS_Z), ZW, 16, (bf16_t*)(F.ws + WS_H), D, F.in[I_MCW], D, F.in[I_MCB], MT);
    for (int t = F.vcu * NTHREADS + F.tid; t < MT * 32; t += F.G * NTHREADS) {
        const int j = t & 31; float v = GT[t] + F.in[I_MBG][j];
        if (j >= 16) v = logsigmoid_f(v);
        GT[t] = v;
    }
    LAS float* scr = (LAS float*)(F.lds + F.wave * 8448); constexpr int I_F1 = (D / 64) * (NFF / 32);
    for (int it = F.gw; it < I_F1; it += F.NGW) transpose_item(F.in[I_FWIN] + (size_t)D * NFF, D, NFF, (bf16_t*)(F.ws + WS_WF1), 0, scr, it, F.lane);
}
__device__ __forceinline__ void ph_e6(Frame& F) {
    const bf16_t* Z = (const bf16_t*)(F.ws + WS_Z); bf16_t* HF = (bf16_t*)(F.ws + WS_HF); const bf16_t* HB = (const bf16_t*)(F.ws + WS_HB);
    const int nthr = F.G * NTHREADS;
    for (int t0 = F.vcu * NTHREADS + F.tid; t0 < MX * 128; t0 += 4 * nthr) {
        u32x4 ov[4], a[4], b[4];
#pragma unroll
        for (int k = 0; k < 4; ++k) { const int t = t0 + k * nthr; const int r = t >> 7, c = (t & 127) * 8;
            if (t < MX * 128) { ov[k] = *(const u32x4*)(Z + (size_t)r * ZW + 2048 + c); a[k] = *(const u32x4*)(HF + (size_t)r * D + c); b[k] = *(const u32x4*)(HB + (size_t)r * D + c); } }
#pragma unroll
        for (int k = 0; k < 4; ++k) { const int t = t0 + k * nthr; const int r = t >> 7, c = (t & 127) * 8;
            if (t < MX * 128) { u32x4 o;
                o.x = pk2(sigmoid_f(bflo(ov[k].x)) * (bflo(a[k].x) + bflo(b[k].x)), sigmoid_f(bfhi(ov[k].x)) * (bfhi(a[k].x) + bfhi(b[k].x)));
                o.y = pk2(sigmoid_f(bflo(ov[k].y)) * (bflo(a[k].y) + bflo(b[k].y)), sigmoid_f(bfhi(ov[k].y)) * (bfhi(a[k].y) + bfhi(b[k].y)));
                o.z = pk2(sigmoid_f(bflo(ov[k].z)) * (bflo(a[k].z) + bflo(b[k].z)), sigmoid_f(bfhi(ov[k].z)) * (bfhi(a[k].z) + bfhi(b[k].z)));
                o.w = pk2(sigmoid_f(bflo(ov[k].w)) * (bflo(a[k].w) + bflo(b[k].w)), sigmoid_f(bfhi(ov[k].w)) * (bfhi(a[k].w) + bfhi(b[k].w)));
                *(u32x4*)(HF + (size_t)r * D + c) = o; } }
    }
}

__device__ __forceinline__ void ph_mlstm_rec(Frame& F) {
    const bf16_t* QK = (const bf16_t*)(F.ws + WS_H); const bf16_t* Z = (const bf16_t*)(F.ws + WS_Z); const float* GT = (const float*)(F.ws + WS_GT);
    bf16_t* HF = (bf16_t*)(F.ws + WS_HF); bf16_t* HB = (bf16_t*)(F.ws + WS_HB);
    LAS float* sq = (LAS float*)(F.lds); LAS float* sk = sq + 64; LAS float* part = sq + 128;
    for (int it = F.vcu; it < 128; it += F.G) {
        const int dir = it & 1, h = (it >> 1) & 7, b = it >> 4, v = F.tid & 127, sub = F.tid >> 7;
        float C[16], n[16];
#pragma unroll
        for (int j = 0; j < 16; ++j) { C[j] = 0.f; n[j] = 0.f; }
        float m = 0.f;
        for (int s = 0; s < CTXL + SEQ; ++s) {
            int r;
            if (s < CTXL) { const int j = dir ? CTXL - 1 - s : s; r = MX + b * CTXL + j; } else { int j = s - CTXL; if (dir) j = SEQ - 1 - j; r = b * SEQ + j; }
            if (F.tid < 64) sq[F.tid] = bf2f(QK[(size_t)r * D + h * 64 + F.tid]); else if (F.tid < 128) sk[F.tid - 64] = bf2f(QK[(size_t)r * D + 512 + h * 64 + (F.tid - 64)]);
            const float vv = bf2f(Z[(size_t)r * ZW + 1024 + h * 128 + v]);
            const float ig = GT[(size_t)r * 32 + dir * 8 + h], lf = GT[(size_t)r * 32 + 16 + dir * 8 + h];
            __syncthreads();
            const float mn = fmaxf(lf + m, ig), fa = __expf(lf + m - mn), fi = __expf(ig - mn);
            float num = 0.f, den = 0.f;
#pragma unroll
            for (int j = 0; j < 16; ++j) { const float kj = sk[sub * 16 + j], qj = sq[sub * 16 + j]; C[j] = fa * C[j] + fi * kj * vv; n[j] = fa * n[j] + fi * kj; num += qj * C[j]; den += qj * n[j]; }
            m = mn;
            part[sub * 128 + v] = num; part[(4 + sub) * 128 + v] = den;
            __syncthreads();
            if (sub == 0 && s >= CTXL) {
                const float nu = (part[v] + part[128 + v]) + (part[256 + v] + part[384 + v]), de = (part[512 + v] + part[640 + v]) + (part[768 + v] + part[896 + v]);
                const float hh = nu / fmaxf(fabsf(de), __expf(-mn)); (dir ? HB : HF)[(size_t)r * D + h * 128 + v] = (bf16_t)f2bf(hh);
            }
        }
        __syncthreads();
    }
}


__device__ __forceinline__ bf16x8 pack8(const f32x4 a, const f32x4 b) {
    u32x4 w; w.x = pg8::cvt_pk_bf16(a[0], a[1]); w.y = pg8::cvt_pk_bf16(a[2], a[3]); w.z = pg8::cvt_pk_bf16(b[0], b[1]); w.w = pg8::cvt_pk_bf16(b[2], b[3]);
    return __builtin_bit_cast(bf16x8, w);
}
__device__ __forceinline__ bf16x8 ld_split(const LAS unsigned char* p) {
    const u32x2 a = *(const LAS u32x2*)p, b = *(const LAS u32x2*)(p + 32);
    u32x4 w; w.x = a.x; w.y = a.y; w.z = b.x; w.w = b.y; return __builtin_bit_cast(bf16x8, w);
}
__device__ __forceinline__ int tok_row(int b, int dir, int c, int s) {
    int p = 64 * c + s;
    if (c < 4) { const int j = dir ? CTXL - 1 - p : p; return MX + b * CTXL + j; }
    p -= CTXL; const int j = dir ? SEQ - 1 - p : p; return b * SEQ + j;
}
#define MFMA16(a, b, c) __builtin_amdgcn_mfma_f32_16x16x32_bf16((a), (b), (c), 0, 0, 0)
__device__ __forceinline__ void ph_mlstm(Frame& F) {
    const bf16_t* QK = (const bf16_t*)(F.ws + WS_H); const bf16_t* Z = (const bf16_t*)(F.ws + WS_Z); const float* GT = (const float*)(F.ws + WS_GT);
    constexpr int RS = 144, TB = 64 * RS, BUFB = 4 * TB, NCH = (CTXL + SEQ) / 64;
    constexpr int TAB_OFF = 2 * BUFB;
    const int lane = F.lane, w = F.wave, l15 = lane & 15, q = lane >> 4, vt = w & 3, th = w >> 2;
    const int tt0 = th ? 1 : 0, tt1 = th ? 2 : 3;
    const f32x4 zero4 = (f32x4){0.f, 0.f, 0.f, 0.f};
    bf16x8 ones; { u32x4 o1 = (u32x4){0x3F803F80u, 0x3F803F80u, 0x3F803F80u, 0x3F803F80u}; ones = __builtin_bit_cast(bf16x8, o1); }
    LAS float* Tb = (LAS float*)(F.lds + TAB_OFF); LAS float* Tu = Tb + NCH * 64; LAS float* TM = Tu + NCH * 64;
    for (int item = F.vcu; item < 256; item += F.G) {
        const int seq = item >> 1, vh = item & 1, dir = seq & 1, h = (seq >> 1) & 7, b = seq >> 4;
        bf16_t* Hout = (bf16_t*)(F.ws + (dir ? WS_HB : WS_HF));
        for (int cc = w; cc < NCH; cc += NWAVES) {
            const int r_ = tok_row(b, dir, cc, lane);
            const float ign = GT[(size_t)r_ * 32 + dir * 8 + h], lfn = GT[(size_t)r_ * 32 + 16 + dir * 8 + h];
            float bb = lfn;
#pragma unroll
            for (int o_ = 1; o_ < 64; o_ <<= 1) { const float t_ = __shfl_up(bb, o_); if (lane >= o_) bb += t_; }
            const float u = ign - bb; float M_ = u;
#pragma unroll
            for (int o_ = 1; o_ < 64; o_ <<= 1) { const float t_ = __shfl_up(M_, o_); if (lane >= o_) M_ = fmaxf(M_, t_); }
            Tb[cc * 64 + lane] = bb; Tu[cc * 64 + lane] = u; TM[cc * 64 + lane] = M_;
        }
        f32x4 Cacc[4], nacc[4];
#pragma unroll
        for (int i = 0; i < 4; ++i) { Cacc[i] = zero4; nacc[i] = zero4; }
        float m_in = 0.f;
        u32x4 qv, kv, vv;
#define ML_LOAD(cc) do { const int r_ = tok_row(b, dir, (cc), lane); \
            qv = *(const u32x4*)(QK + (size_t)r_ * D + h * 64 + 8 * w); kv = *(const u32x4*)(QK + (size_t)r_ * D + 512 + h * 64 + 8 * w); \
            vv = *(const u32x4*)(Z + (size_t)r_ * ZW + 1024 + h * 128 + vh * 64 + 8 * w); } while (0)
#define ML_WRITE(cc, mi) do { \
            const float mm63_ = fmaxf((mi), TM[(cc) * 64 + 63]); const float wg_ = __expf(Tu[(cc) * 64 + lane] - mm63_); \
            LAS unsigned char* B_ = F.lds + ((cc) & 1) * BUFB; \
            *(LAS u32x4*)(B_ + lane * RS + 16 * w) = qv; *(LAS u32x4*)(B_ + TB + lane * RS + 16 * w) = kv; \
            { const unsigned kw_[4] = {kv.x, kv.y, kv.z, kv.w}, vw_[4] = {vv.x, vv.y, vv.z, vv.w}; \
              _Pragma("unroll") for (int i_ = 0; i_ < 4; ++i_) { \
                *(LAS unsigned short*)(B_ + 2 * TB + (8 * w + 2 * i_) * RS + 2 * lane) = (unsigned short)f2bf(bflo(kw_[i_]) * wg_); \
                *(LAS unsigned short*)(B_ + 2 * TB + (8 * w + 2 * i_ + 1) * RS + 2 * lane) = (unsigned short)f2bf(bfhi(kw_[i_]) * wg_); \
                *(LAS unsigned short*)(B_ + 3 * TB + (8 * w + 2 * i_) * RS + 2 * lane) = (unsigned short)(vw_[i_] & 0xffffu); \
                *(LAS unsigned short*)(B_ + 3 * TB + (8 * w + 2 * i_ + 1) * RS + 2 * lane) = (unsigned short)(vw_[i_] >> 16); } } } while (0)
        ML_LOAD(0);
        __syncthreads();
        ML_WRITE(0, m_in);
        __syncthreads();
        for (int c = 0; c < NCH; ++c) {
            if (c + 1 < NCH) ML_LOAD(c + 1);
            const LAS unsigned char* QS = F.lds + (c & 1) * BUFB; const LAS unsigned char* KS = QS + TB; const LAS unsigned char* KT = QS + 2 * TB; const LAS unsigned char* VT = QS + 3 * TB;
            const float M63 = TM[c * 64 + 63], mm63 = fmaxf(m_in, M63), adec = __expf(m_in - mm63);
            if (c >= 4) {
                f32x4 us[4];
#pragma unroll
                for (int ss = 0; ss < 4; ++ss) us[ss] = *(const LAS f32x4*)(Tu + c * 64 + 16 * ss + 4 * q);
                const bf16x8 ca0 = pack8(Cacc[0], Cacc[1]), ca1 = pack8(Cacc[2], Cacc[3]), na0 = pack8(nacc[0], nacc[1]), na1 = pack8(nacc[2], nacc[3]);
                const bf16x8 va0 = ld_split(VT + (16 * vt + l15) * RS + 8 * q), va1 = ld_split(VT + (16 * vt + l15) * RS + 64 + 8 * q);
#pragma unroll
                for (int ti = 0; ti < 2; ++ti) {
                    const int tt = ti ? tt1 : tt0, tl = 16 * tt + l15;
                    const float mmt = fmaxf(m_in, TM[c * 64 + tl]), bt = Tb[c * 64 + tl];
                    const bf16x8 qn0 = *(const LAS bf16x8*)(QS + tl * RS + 16 * q), qn1 = *(const LAS bf16x8*)(QS + tl * RS + 64 + 16 * q);
                    f32x4 PT[4];
#pragma unroll
                    for (int ss = 0; ss < 4; ++ss) {
                        if (ss <= tt) {
                            const bf16x8 k0 = *(const LAS bf16x8*)(KS + (16 * ss + l15) * RS + 16 * q), k1 = *(const LAS bf16x8*)(KS + (16 * ss + l15) * RS + 64 + 16 * q);
                            f32x4 a = MFMA16(k0, qn0, zero4); a = MFMA16(k1, qn1, a);
#pragma unroll
                            for (int i = 0; i < 4; ++i) { const int sp = 16 * ss + 4 * q + i; const float wgt = __expf(us[ss][i] - mmt); a[i] = (sp <= tl) ? a[i] * wgt : 0.f; }
                            PT[ss] = a;
                        } else PT[ss] = zero4;
                    }
                    const bf16x8 pb0 = pack8(PT[0], PT[1]), pb1 = pack8(PT[2], PT[3]);
                    f32x4 aPV = MFMA16(va0, pb0, zero4); aPV = MFMA16(va1, pb1, aPV);
                    f32x4 rsum = MFMA16(ones, pb0, zero4); rsum = MFMA16(ones, pb1, rsum);
                    const bf16x8 qs0 = ld_split(QS + tl * RS + 8 * q), qs1 = ld_split(QS + tl * RS + 64 + 8 * q);
                    f32x4 aQC = MFMA16(ca0, qs0, zero4); aQC = MFMA16(ca1, qs1, aQC);
                    f32x4 qn = MFMA16(na0, qs0, zero4); qn = MFMA16(na1, qs1, qn);
                    const float at = __expf(m_in - mmt), fl = __expf(-(bt + mmt));
                    float hh[4];
#pragma unroll
                    for (int i = 0; i < 4; ++i) { const float den = rsum[i] + at * qn[i]; hh[i] = (aPV[i] + at * aQC[i]) * __builtin_amdgcn_rcpf(fmaxf(fabsf(den), fl)); }
                    const int row = tok_row(b, dir, c, tl);
                    u32x2 o; o.x = pk2(hh[0], hh[1]); o.y = pk2(hh[2], hh[3]);
                    *(u32x2*)(Hout + (size_t)row * D + h * 128 + vh * 64 + vt * 16 + 4 * q) = o;
                }
            }
            {
                const bf16x8 vb0 = *(const LAS bf16x8*)(VT + (16 * vt + l15) * RS + 16 * q), vb1 = *(const LAS bf16x8*)(VT + (16 * vt + l15) * RS + 64 + 16 * q);
#pragma unroll
                for (int dt = 0; dt < 4; ++dt) {
                    const bf16x8 kt0 = *(const LAS bf16x8*)(KT + (16 * dt + l15) * RS + 16 * q), kt1 = *(const LAS bf16x8*)(KT + (16 * dt + l15) * RS + 64 + 16 * q);
                    f32x4 cc = Cacc[dt] * adec, nn = nacc[dt] * adec;
                    cc = MFMA16(kt0, vb0, cc); cc = MFMA16(kt1, vb1, cc); nn = MFMA16(kt0, ones, nn); nn = MFMA16(kt1, ones, nn);
                    Cacc[dt] = cc; nacc[dt] = nn;
                }
            }
            m_in = Tb[c * 64 + 63] + mm63;
            if (c + 1 < NCH) ML_WRITE(c + 1, m_in);
            __syncthreads();
        }
#undef ML_LOAD
#undef ML_WRITE
    }
}

#ifndef USE_MFMA_GEMM
#define USE_MFMA_GEMM 1
#endif
#ifndef SINGLE_LAUNCH
#define SINGLE_LAUNCH 1
#endif
#ifndef NAIVE_MLSTM
#define NAIVE_MLSTM 0
#endif
#ifndef REP_MASK
#define REP_MASK 0
#endif
#ifndef MLSTM_REC
#define MLSTM_REC 0
#endif
template <class Epi, bool ALIGN>
__device__ __forceinline__ void run_gemm(Frame& F, const bf16_t* A, const bf16_t* Bt, int M, int N, int K, int lda, int ldb, int akoff, const Epi& E) {
    pg8::Gemm g{A, Bt, M, N, K, lda, ldb, akoff}; pg8::StaticOrder S; S.init(M, N, K, F.G, (int)blockIdx.x);
    pg8::gemm_phase<Epi, pg8::StaticOrder, ALIGN>(F.lds + RING_OFF, g, S, E);
}

__global__ void __launch_bounds__(NTHREADS, 2) mega(P args) {
    extern __shared__ __attribute__((aligned(16))) unsigned char lds[];
    Frame F;
    F.lds = (LAS unsigned char*)lds;
    F.tid = threadIdx.x; F.lane = F.tid & 63; F.wave = __builtin_amdgcn_readfirstlane(F.tid >> 6);
    F.G = gridDim.x; { const int bx = blockIdx.x; F.vcu = (F.G % 8 == 0) ? (bx % 8) * (F.G / 8) + bx / 8 : bx; }
    F.gw = F.vcu * NWAVES + F.wave; F.NGW = F.G * NWAVES;
#pragma unroll
    for (int i = 0; i < 18; ++i) F.in[i] = args.in[i];
    F.out = args.out; F.ws = args.ws;
    volatile LAS unsigned* MISC = (volatile LAS unsigned*)(F.lds + MISC_OFF);
    for (int u = F.tid; u < (LDS_BYTES - LDSCTL_OFF) / 4; u += NTHREADS) ((LAS unsigned*)(F.lds + LDSCTL_OFF))[u] = 0u;
    __syncthreads();
    const int lo = args.lo, hi = args.hi;
    XcdBarrier bar; bar.bar = (unsigned*)(F.ws + WS_CTL) + CW_BAR; bar.x = 0; bar.st = nullptr;
    if (hi - lo > 1) bar = xcd_barrier_post((unsigned*)(F.ws + WS_CTL) + CW_BAR, MISC + 8);
#define IN(k) (lo <= (k) && (k) < hi)
#define SEAM(k) do { if (IN(k) && IN((k) + 1)) xcd_barrier(bar); } while (0)
    unsigned char* ws = F.ws;
    if (IN(PH_P0)) { ph_p0(F); } SEAM(PH_P0);
    if (IN(PH_POOL)) { ph_pool(F); } SEAM(PH_POOL);
    if (IN(PH_G1)) { pg8::EpiBf16 E{(bf16_t*)(ws + WS_Y0), D}; run_gemm<pg8::EpiBf16, true>(F, (const bf16_t*)(ws + WS_H), (const bf16_t*)(ws + WS_WP), MT, D, 256, D, 256, 256, E); } SEAM(PH_G1);
    if (IN(PH_E2)) { ph_e2(F); } SEAM(PH_E2);
    if (IN(PH_G2)) { pg8::EpiBf16 E{(bf16_t*)(ws + WS_UG0), NFF}; run_gemm<pg8::EpiBf16, true>(F, (const bf16_t*)(ws + WS_H), (const bf16_t*)(ws + WS_WF1), MT, NFF, D, D, D, 0, E); } SEAM(PH_G2);
    if (IN(PH_E3)) { ph_e3(F); } SEAM(PH_E3);
    if (IN(PH_G3)) { pg8::EpiBf16Split E{(bf16_t*)(ws + WS_H), (bf16_t*)(ws + WS_FXP), D};
        pg8::Gemm g{(const bf16_t*)(ws + WS_UG0), (const bf16_t*)(ws + WS_WF2A), MT, D, DFF, NFF, DFF, 0}; pg8::G3Order S; S.init(F.G, (int)blockIdx.x);
        pg8::gemm_phase<pg8::EpiBf16Split, pg8::G3Order, true>(F.lds + RING_OFF, g, S, E); } SEAM(PH_G3);
    if (IN(PH_E4)) { ph_e4(F); } SEAM(PH_E4);
    if (IN(PH_G4)) { pg8::EpiZ E{(bf16_t*)(ws + WS_Z), (float*)(ws + WS_GT)}; run_gemm<pg8::EpiZ, true>(F, (const bf16_t*)(ws + WS_H), (const bf16_t*)(ws + WS_WI), MT, INWP, D, D, D, 0, E); } SEAM(PH_G4);
    if (IN(PH_E5)) { ph_e5(F); } SEAM(PH_E5);
    if (IN(PH_MLSTM)) {
#if MLSTM_REC
        ph_mlstm_rec(F);
#else
        ph_mlstm(F);
#endif
    } SEAM(PH_MLSTM);
    if (IN(PH_E6)) { ph_e6(F); } SEAM(PH_E6);
    if (IN(PH_G5)) { pg8::EpiBf16 E{(bf16_t*)(ws + WS_Y1), D}; run_gemm<pg8::EpiBf16, true>(F, (const bf16_t*)(ws + WS_HF), (const bf16_t*)(ws + WS_WO), MX, D, D, D, D, 0, E); } SEAM(PH_G5);
    if (IN(PH_E7)) { ph_e7(F); } SEAM(PH_E7);
    if (IN(PH_G6)) { pg8::EpiBf16 E{(bf16_t*)(ws + WS_UG1), NFF}; run_gemm<pg8::EpiBf16, true>(F, (const bf16_t*)(ws + WS_H), (const bf16_t*)(ws + WS_WF1), MX, NFF, D, D, D, 0, E); } SEAM(PH_G6);
    if (IN(PH_E8)) { bf16_t* UG = (bf16_t*)(ws + WS_UG1); ph_conv<0>(F, UG + DFF, NFF, 44, UG, NFF, F.in[I_FCW] + 9 * DFF, DFF, F.in[I_FCB] + DFF, MX); } SEAM(PH_E8);
    if (IN(PH_G7)) { pg8::EpiBf16 E{(bf16_t*)(ws + WS_H), D}; run_gemm<pg8::EpiBf16, true>(F, (const bf16_t*)(ws + WS_UG1), (const bf16_t*)(ws + WS_WF2B), MX, D, DFF, NFF, DFF, 0, E); } SEAM(PH_G7);
    if (IN(PH_E9)) { ph_e9(F); }
#undef IN
#undef SEAM
}

__global__ void __launch_bounds__(256) k_gemm_naive(const bf16_t* A, const bf16_t* Bt, int K, int lda, int ldb, int akoff, int mode, void* O, int ldc, float* GT) {
    __shared__ float As[16][65], Bs[16][65];
    const int n0 = blockIdx.x * 64, m0 = blockIdx.y * 64, tx = threadIdx.x & 15, ty = threadIdx.x >> 4;
    const bf16_t* Ab = A + (size_t)(n0 / 256) * akoff;
    float acc[4][4];
#pragma unroll
    for (int i = 0; i < 4; ++i)
#pragma unroll
        for (int j = 0; j < 4; ++j) acc[i][j] = 0.f;
    for (int k0 = 0; k0 < K; k0 += 16) {
        for (int i = threadIdx.x; i < 64 * 16; i += 256) { const int rr = i >> 4, kk = i & 15; As[kk][rr] = bf2f(Ab[(size_t)(m0 + rr) * lda + k0 + kk]); Bs[kk][rr] = bf2f(Bt[(size_t)(n0 + rr) * ldb + k0 + kk]); }
        __syncthreads();
#pragma unroll
        for (int kk = 0; kk < 16; ++kk) {
            float a[4], b[4];
#pragma unroll
            for (int i = 0; i < 4; ++i) { a[i] = As[kk][ty * 4 + i]; b[i] = Bs[kk][tx * 4 + i]; }
#pragma unroll
            for (int i = 0; i < 4; ++i)
#pragma unroll
                for (int j = 0; j < 4; ++j) acc[i][j] += a[i] * b[j];
        }
        __syncthreads();
    }
#pragma unroll
    for (int i = 0; i < 4; ++i)
#pragma unroll
        for (int j = 0; j < 4; ++j) {
            const int r = m0 + ty * 4 + i, c = n0 + tx * 4 + j;
            if (mode == 0) ((float*)O)[(size_t)r * ldc + c] = acc[i][j];
            else if (mode == 1) ((bf16_t*)O)[(size_t)r * ldc + c] = (bf16_t)f2bf(acc[i][j]);
            else { if (c < ZW) ((bf16_t*)O)[(size_t)r * ZW + c] = (bf16_t)f2bf(acc[i][j]); else if (c < ZW + 32) GT[(size_t)r * 32 + (c - ZW)] = acc[i][j]; }
        }
}
__global__ void __launch_bounds__(128) k_mlstm_naive(const bf16_t* QK, const bf16_t* Z, const float* GT, bf16_t* HF, bf16_t* HB) {
    const int bid = blockIdx.x, dir = bid & 1, h = (bid >> 1) & 7, b = bid >> 4, v = threadIdx.x;
    __shared__ float sq[64], sk[64];
    float C[64], n[64];
#pragma unroll
    for (int j = 0; j < 64; ++j) { C[j] = 0.f; n[j] = 0.f; }
    float m = 0.f;
    for (int s = 0; s < CTXL + SEQ; ++s) {
        int r;
        if (s < CTXL) { const int j = dir ? CTXL - 1 - s : s; r = MX + b * CTXL + j; } else { int j = s - CTXL; if (dir) j = SEQ - 1 - j; r = b * SEQ + j; }
        if (v < 64) sq[v] = bf2f(QK[(size_t)r * D + h * 64 + v]); else sk[v - 64] = bf2f(QK[(size_t)r * D + 512 + h * 64 + (v - 64)]);
        const float vv = bf2f(Z[(size_t)r * ZW + 1024 + h * 128 + v]);
        const float ig = GT[(size_t)r * 32 + dir * 8 + h], lf = GT[(size_t)r * 32 + 16 + dir * 8 + h];
        __syncthreads();
        const float mn = fmaxf(lf + m, ig), fa = __expf(lf + m - mn), fi = __expf(ig - mn);
        float num = 0.f, den = 0.f;
#pragma unroll
        for (int j = 0; j < 64; ++j) { const float kj = sk[j]; C[j] = fa * C[j] + fi * kj * vv; n[j] = fa * n[j] + fi * kj; num += sq[j] * C[j]; den += sq[j] * n[j]; }
        m = mn;
        if (s >= CTXL) { const float hh = num / fmaxf(fabsf(den), __expf(-mn)); (dir ? HB : HF)[(size_t)r * D + h * 128 + v] = (bf16_t)f2bf(hh); }
        __syncthreads();
    }
}

static void launch_naive_gemm(hipStream_t s, const bf16_t* A, const bf16_t* Bt, int M, int N, int K, int lda, int ldb, int akoff, int mode, void* O, int ldc, float* GT) {
    hipLaunchKernelGGL(k_gemm_naive, dim3(N / 64, M / 64), dim3(256), 0, s, A, Bt, K, lda, ldb, akoff, mode, O, ldc, GT);
}
extern "C" void kernel_launch(void* const* d_in, const int* in_sizes, int n_in, void* d_out, int out_size, void* d_ws, size_t ws_size, hipStream_t stream) {
    static int grid = 0;
    if (grid == 0) {
        if (n_in != 18 || out_size != MX * D || ws_size < WS_END) { fprintf(stderr, "kernel_launch: unexpected shapes n_in %d out %d ws %zu\n", n_in, out_size, ws_size); grid = -1; return; }
        int dev = 0, cus = 0, per_cu = 0;
        (void)hipGetDevice(&dev); (void)hipDeviceGetAttribute(&cus, hipDeviceAttributeMultiprocessorCount, dev);
        (void)hipFuncSetAttribute((const void*)mega, hipFuncAttributeMaxDynamicSharedMemorySize, LDS_BYTES);
        (void)hipOccupancyMaxActiveBlocksPerMultiprocessor(&per_cu, (const void*)mega, NTHREADS, LDS_BYTES);
        (void)hipGetLastError();
        if (per_cu < 1) fprintf(stderr, "kernel_launch: occupancy query says %d blocks/CU\n", per_cu);
        grid = cus;
    }
    if (grid < 0) return;
    (void)hipMemsetAsync((char*)d_ws + WS_CTL, 0, CTL_ZERO_BYTES, stream);
    P a{};
    for (int i = 0; i < 18; ++i) a.in[i] = (const float*)d_in[i];
    a.out = (float*)d_out; a.ws = (unsigned char*)d_ws;
    unsigned char* ws = (unsigned char*)d_ws;
#if SINGLE_LAUNCH
    a.lo = 0; a.hi = NPH;
    hipLaunchKernelGGL(mega, dim3(grid), dim3(NTHREADS), LDS_BYTES, stream, a);
    return;
#endif
    for (int ph = 0; ph < NPH; ++ph) {
        if (ph == PH_MLSTM && NAIVE_MLSTM) {
            hipLaunchKernelGGL(k_mlstm_naive, dim3(128), dim3(128), 0, stream, (const bf16_t*)(ws + WS_H), (const bf16_t*)(ws + WS_Z), (const float*)(ws + WS_GT), (bf16_t*)(ws + WS_HF), (bf16_t*)(ws + WS_HB));
            continue;
        }
        a.lo = ph; a.hi = ph + 1;
        for (int rep = 0; rep < 1 + (((REP_MASK) >> ph) & 1); ++rep) hipLaunchKernelGGL(mega, dim3(grid), dim3(NTHREADS), LDS_BYTES, stream, a);
    }
}
```
